# Optimizing an MI355X kernel written in HIP

```python
import math
import jax, jax.numpy as jnp
from jax import lax
import numpy as np

D_MODEL = 1024
BATCH = 4
SEQ = 4096
DEPTH = 1

POOL_WIDTH = D_MODEL // 2
POOL_WINDOWS = (2, 4, 8, 16)
N_POOL_GROUPS = 4
POOL_GROUP = POOL_WIDTH // N_POOL_GROUPS
HEAD_DIM = 64
N_Q_HEADS = (D_MODEL // 2) // HEAD_DIM
N_KV_HEADS = N_Q_HEADS // 4
Q_PER_KV = N_Q_HEADS // N_KV_HEADS
ATTN_WIDTH = N_Q_HEADS * HEAD_DIM
KV_WIDTH = N_KV_HEADS * HEAD_DIM
WINDOW = 128
BLOCK = 128
N_BUCKETS = 32
MAX_DISTANCE = 128
N_EXPERTS = 32
TOP_K = 4
D_FF = D_MODEL
SWIGLU_LIMIT = 7.0
SWIGLU_ALPHA = 1.702
RMS_EPS = 1e-5
IN_WIDTH = POOL_WIDTH + ATTN_WIDTH + 2 * KV_WIDTH + 2 * D_MODEL
SPLITS = (POOL_WIDTH,
          POOL_WIDTH + ATTN_WIDTH,
          POOL_WIDTH + ATTN_WIDTH + KV_WIDTH,
          POOL_WIDTH + ATTN_WIDTH + 2 * KV_WIDTH,
          POOL_WIDTH + ATTN_WIDTH + 2 * KV_WIDTH + D_MODEL)

kernel_name = "hybrid_pool_swa_sink_moe"


def rmsnorm(x, g):
    xf = x.astype(jnp.float32)
    y = xf * lax.rsqrt(jnp.mean(xf * xf, axis=-1, keepdims=True) + RMS_EPS)
    return (y * g.astype(jnp.float32)).astype(x.dtype)


def t5_bucket(dist):
    max_exact = N_BUCKETS // 2
    d = np.maximum(dist, 1).astype(np.float32)
    large = max_exact + (np.log(d / max_exact) / math.log(MAX_DISTANCE / max_exact)
                         * (N_BUCKETS - max_exact)).astype(np.int32)
    large = np.minimum(large, N_BUCKETS - 1)
    return np.where(dist < max_exact, dist, large).astype(np.int32)


def multiscale_pool(u, pool_w, pool_scale):
    B, S, _ = u.shape
    ug = u.reshape(B, S, N_POOL_GROUPS, POOL_GROUP).astype(jnp.float32)
    cs = jnp.cumsum(ug, axis=1)
    cs0 = jnp.pad(cs, ((0, 0), (1, 0), (0, 0), (0, 0)))
    pos = jnp.arange(1, S + 1, dtype=jnp.float32)
    means = []
    for g, w in enumerate(POOL_WINDOWS):
        lo = jnp.pad(cs0[:, :S + 1 - w, g], ((0, 0), (w - 1, 0), (0, 0)))
        cnt = jnp.minimum(pos, float(w))[None, :, None]
        means.append((cs[:, :, g] - lo) / cnt)
    z = (jnp.stack(means, axis=2) - ug).astype(u.dtype)
    z = jnp.einsum('bsgc,gcd->bsgd', z, pool_w)
    return z.reshape(B, S, POOL_WIDTH) * pool_scale


def sliding_window_attention(q, k, v, sinks, rel_bias):
    B, S, _ = q.shape
    nb = S // BLOCK
    qb = q.reshape(B, nb, BLOCK, N_KV_HEADS, Q_PER_KV, HEAD_DIM)
    k4 = k.reshape(B, S, N_KV_HEADS, HEAD_DIM)
    v4 = v.reshape(B, S, N_KV_HEADS, HEAD_DIM)
    pad = ((0, 0), (BLOCK, 0), (0, 0), (0, 0))
    kp, vp = jnp.pad(k4, pad), jnp.pad(v4, pad)
    blk = (B, nb, BLOCK, N_KV_HEADS, HEAD_DIM)
    kb = jnp.concatenate([kp[:, :S].reshape(blk), k4.reshape(blk)], axis=2)
    vb = jnp.concatenate([vp[:, :S].reshape(blk), v4.reshape(blk)], axis=2)

    qi = np.arange(BLOCK)[:, None]
    kj = np.arange(2 * BLOCK)[None, :]
    dist = BLOCK + qi - kj
    in_band = (dist >= 0) & (dist < WINDOW)
    bucket = t5_bucket(np.clip(dist, 0, None))
    bias = jnp.transpose(rel_bias[bucket].astype(jnp.float32), (2, 0, 1))
    bias = bias.reshape(N_KV_HEADS, Q_PER_KV, BLOCK, 2 * BLOCK)
    kpos = (np.arange(nb)[:, None, None] - 1) * BLOCK + kj[None]
    mask = in_band[None] & (kpos >= 0)

    scores = jnp.einsum('bnqhgd,bnkhd->bnhgqk', qb, kb,
                        preferred_element_type=jnp.float32) * (HEAD_DIM ** -0.5)
    scores = jnp.where(mask[None, :, None, None], scores + bias[None, None], -1e30)
    sink = jnp.broadcast_to(sinks.astype(jnp.float32).reshape(1, 1, N_KV_HEADS, Q_PER_KV, 1, 1),
                            scores.shape[:-1] + (1,))
    probs = jax.nn.softmax(jnp.concatenate([scores, sink], axis=-1), axis=-1)[..., :-1]
    out = jnp.einsum('bnhgqk,bnkhd->bnqhgd', probs.astype(v.dtype), vb)
    return out.reshape(B, S, ATTN_WIDTH)


def clamped_swiglu(hu):
    glu, lin = hu[..., ::2], hu[..., 1::2]
    glu = jnp.minimum(glu, SWIGLU_LIMIT)
    lin = jnp.clip(lin, -SWIGLU_LIMIT, SWIGLU_LIMIT)
    return glu * jax.nn.sigmoid(SWIGLU_ALPHA * glu) * (lin + 1.0)


def moe(h, w_router, b_router, w_up, b_up, w_down, b_down):
    B, S, D = h.shape
    t = h.reshape(-1, D)
    logits = (t @ w_router + b_router).astype(jnp.float32)
    top_vals, top_idx = lax.top_k(logits, TOP_K)
    top_w = jax.nn.softmax(top_vals, axis=-1)
    gates = jnp.einsum('tk,tke->te', top_w, jax.nn.one_hot(top_idx, N_EXPERTS, dtype=jnp.float32))
    out = jnp.zeros((t.shape[0], D), jnp.float32)
    for e in range(N_EXPERTS):
        act = clamped_swiglu(t @ w_up[e] + b_up[e])
        out = out + gates[:, e:e + 1] * (act @ w_down[e] + b_down[e]).astype(jnp.float32)
    return out.astype(h.dtype).reshape(B, S, D)


def setup_inputs(seed: int = 0) -> dict:
    key = jax.random.key(seed)
    ks = jax.random.split(key, 20)
    f32 = jnp.float32
    n = lambda k, shape, s: jax.random.normal(k, shape, f32) * s
    return {
        "x": n(ks[0], (BATCH, SEQ, D_MODEL), 1.0),
        "norm1_g": 1.0 + n(ks[1], (DEPTH, D_MODEL), 0.02),
        "w_in": n(ks[2], (DEPTH, D_MODEL, IN_WIDTH), D_MODEL ** -0.5),
        "pool_w": n(ks[3], (DEPTH, N_POOL_GROUPS, POOL_GROUP, POOL_GROUP), POOL_GROUP ** -0.5),
        "pool_scale": 1.0 + n(ks[4], (DEPTH, POOL_WIDTH), 0.02),
        "w_pool_proj": n(ks[5], (DEPTH, POOL_WIDTH, D_MODEL), POOL_WIDTH ** -0.5),
        "sinks": n(ks[6], (DEPTH, N_Q_HEADS), 1.0),
        "w_attn_proj": n(ks[7], (DEPTH, ATTN_WIDTH, D_MODEL), ATTN_WIDTH ** -0.5),
        "w_out": n(ks[8], (DEPTH, D_MODEL, D_MODEL), D_MODEL ** -0.5),
        "norm2_g": 1.0 + n(ks[9], (DEPTH, D_MODEL), 0.02),
        "w_router": n(ks[10], (DEPTH, D_MODEL, N_EXPERTS), D_MODEL ** -0.5),
        "b_router": n(ks[11], (DEPTH, N_EXPERTS), 0.01),
        "w_up": n(ks[12], (DEPTH, N_EXPERTS, D_MODEL, 2 * D_FF), D_MODEL ** -0.5),
        "b_up": n(ks[13], (DEPTH, N_EXPERTS, 2 * D_FF), 0.01),
        "w_down": n(ks[14], (DEPTH, N_EXPERTS, D_FF, D_MODEL), D_FF ** -0.5),
        "b_down": n(ks[15], (DEPTH, N_EXPERTS, D_MODEL), 0.01),
        "rel_bias": n(ks[16], (N_BUCKETS, N_Q_HEADS), 0.5),
        "final_g": 1.0 + n(ks[17], (D_MODEL,), 0.02),
    }


def reference(x, norm1_g, w_in, pool_w, pool_scale, w_pool_proj, sinks, w_attn_proj, w_out,
              norm2_g, w_router, b_router, w_up, b_up, w_down, b_down, rel_bias, final_g):
    for l in range(DEPTH):
        h = rmsnorm(x, norm1_g[l])
        u, q, k, v, g_pool, g_attn = jnp.split(h @ w_in[l], SPLITS, axis=-1)
        y_pool = multiscale_pool(u, pool_w[l], pool_scale[l]) @ w_pool_proj[l]
        y_attn = sliding_window_attention(q, k, v, sinks[l], rel_bias) @ w_attn_proj[l]
        mixed = jax.nn.sigmoid(g_pool) * y_pool + jax.nn.sigmoid(g_attn) * y_attn
        x = x + mixed @ w_out[l]
        x = x + moe(rmsnorm(x, norm2_g[l]), w_router[l], b_router[l], w_up[l], b_up[l],
                    w_down[l], b_down[l])
    return rmsnorm(x, final_g)
```

```cpp
#include <hip/hip_runtime.h>
#include <cstdio>
#include <cstdint>

#ifndef MK_N_LAUNCHES
#define MK_N_LAUNCHES 1
#endif

constexpr int T_TOK = 16384, DM = 1024, SEQ = 4096, NB = 4;
constexpr int INW = 3328;
constexpr int NEXP = 32, TOPK = 4, DFF = 1024;
constexpr int CAP = 16384;
constexpr int NRT_MAX = 288;
constexpr int SLOT_ROWS = NRT_MAX * 256;
constexpr float RMS_EPS = 1e-5f;
constexpr float LOG2E = 1.4426950408889634f;

namespace pg8 {
#define PG8_LAS __attribute__((address_space(3)))
typedef unsigned short bf16_t;
typedef short bf16x8 __attribute__((ext_vector_type(8)));
typedef float f32x4 __attribute__((ext_vector_type(4)));
typedef float f32x2 __attribute__((ext_vector_type(2)));
typedef unsigned u32x4 __attribute__((ext_vector_type(4)));
typedef unsigned u32x2 __attribute__((ext_vector_type(2)));
constexpr int BM = 256, BK = 64, HALF = 128, HTB = HALF * BK * 2, STAGE_BYTES = 8 * HTB, NXCD = 8, WGM = 8;
constexpr int GK = 1024;

__host__ __device__ __forceinline__ int lds_byte(int r, int c) { const int st = (r >> 4) * 2 + (c >> 5), rr = r & 15, cc = c & 31, ob = rr * 64 + cc * 2; return st * 1024 + (ob ^ (((ob >> 9) & 1) << 5)); }
__host__ __device__ __forceinline__ void stage_rc(int b, int& R, int& C) { const int st = b / 1024, sb = b % 1024, swz = sb ^ (((sb >> 9) & 1) << 5); R = (st >> 1) * 16 + swz / 64; C = (st & 1) * 32 + (swz % 64) / 2; }
__host__ __device__ __forceinline__ int perm32(int rho) { const int n = rho >> 4, i = rho & 15; return 8 * (i >> 2) + 4 * n + (i & 3); }

struct Unit { int pm, pn; };
typedef int v4i_t __attribute__((ext_vector_type(4)));
typedef int v8i_t __attribute__((ext_vector_type(8)));
__device__ __forceinline__ v8i_t cat8(bf16x8 lo, bf16x8 hi) { return __builtin_shufflevector(__builtin_bit_cast(v4i_t, lo), __builtin_bit_cast(v4i_t, hi), 0, 1, 2, 3, 4, 5, 6, 7); }

struct StaticOrder {
    static constexpr bool WAITS = false, PUBLISHES = false;
    int nM, nN, nwg, G, c;
    __host__ __device__ void init(int nM_, int nN_, int G_, int c_) { nM = nM_; nN = nN_; nwg = nM * nN; G = G_; c = c_; }
    __host__ __device__ bool next(int i, Unit& u) const {
        const long L = (long)i * G + c; if (L >= nwg) return false;
        int wgid = (int)L; { const int q = nwg / NXCD, r = nwg % NXCD, xcd = wgid % NXCD, off = wgid / NXCD; wgid = (xcd < r ? xcd * (q + 1) : r * (q + 1) + (xcd - r) * q) + off; }
        const int nig = WGM * nN, gid = wgid / nig, fm = gid * WGM, gsz = (nM - fm) < WGM ? (nM - fm) : WGM;
        u.pm = fm + ((wgid % nig) % gsz); u.pn = (wgid % nig) / gsz; return true;
    }
};

__device__ __forceinline__ void glds16s(const char* sbase, unsigned voff, unsigned lds_dst) { unsigned keep;
    asm volatile("s_mov_b32 %0, m0\n\ts_mov_b32 m0, %3\n\ts_nop 2\n\tglobal_load_lds_dwordx4 %1, %2\n\ts_mov_b32 m0, %0" : "=&s"(keep) : "v"(voff), "s"(sbase), "s"(lds_dst) : "memory"); }
struct XccOrder {
    static constexpr bool WAITS = false, PUBLISHES = false;
    int r0, nr, nN, n, skip, r;
    __host__ __device__ void init(int nM, int nN_, int x, int r_, int skip_) { r0 = x * nM / NXCD; nr = (x + 1) * nM / NXCD - r0; nN = nN_; n = nr * nN; skip = skip_; r = r_; }
    __host__ __device__ int first_i() const { return skip <= r ? 0 : (skip - r + 31) / 32; }
    __host__ __device__ bool next(int i, Unit& u) const {
        const int k = (i + first_i()) * 32 + r - skip; if (k < 0 || k >= n) return false;
        const int nig = WGM * nN, gid = k / nig, fm = gid * WGM, gsz = (nr - fm) < WGM ? (nr - fm) : WGM;
        u.pm = r0 + fm + ((k % nig) % gsz); u.pn = (k % nig) / gsz; return true;
    }
};
struct XccProducer : XccOrder {
    static constexpr bool WAITS = false, PUBLISHES = true;
    unsigned* cnt;
    __device__ __forceinline__ void publish(const Unit& u) const {
        if ((threadIdx.x & 63) == 0) __hip_atomic_fetch_add(cnt + 64 * u.pm, 1u, __ATOMIC_RELAXED, __HIP_MEMORY_SCOPE_AGENT); }
};
struct XccConsumer : XccOrder {
    static constexpr bool WAITS = true, PUBLISHES = false;
    unsigned* cnt; unsigned* tmo;
    __device__ __forceinline__ void a_ready(const Unit& u) const {
        if (threadIdx.x < 64) {
            unsigned sp = 0u;
            while ((unsigned)__builtin_amdgcn_readfirstlane(__hip_atomic_load(cnt + 64 * u.pm, __ATOMIC_RELAXED, __HIP_MEMORY_SCOPE_AGENT)) < 64u) {
                __builtin_amdgcn_s_sleep(2);
                if ((++sp & 255u) == 0u) { if (__builtin_amdgcn_readfirstlane(__hip_atomic_load(tmo, __ATOMIC_RELAXED, __HIP_MEMORY_SCOPE_AGENT)) != 0u) break;
                    if (sp > (1u << 20)) { if (threadIdx.x == 0) __hip_atomic_store(tmo, 1u, __ATOMIC_RELAXED, __HIP_MEMORY_SCOPE_AGENT); break; } } }
            __builtin_amdgcn_fence(__ATOMIC_ACQUIRE, "agent");
            asm volatile("s_waitcnt vmcnt(0)" ::: "memory");
        }
        asm volatile("" ::: "memory"); __builtin_amdgcn_s_barrier(); asm volatile("" ::: "memory");
    }
};
__device__ __forceinline__ unsigned cvt_pk_bf16(float lo, float hi) { unsigned r; asm volatile("v_cvt_pk_bf16_f32 %0, %1, %2" : "=v"(r) : "v"(lo), "v"(hi)); return r; }
__device__ __forceinline__ float bf_lo(unsigned w) { return __uint_as_float(w << 16); }
__device__ __forceinline__ float bf_hi(unsigned w) { return __uint_as_float(w & 0xffff0000u); }

template <class Prob, class Epi, class Sched, bool ALIGN_EPI>
__device__ __forceinline__ void gemm_phase(PG8_LAS unsigned char* lds, const Prob& P, const Sched& S, const Epi& E) {
    const int tid = threadIdx.x, wid = __builtin_amdgcn_readfirstlane(tid >> 6), lane = tid & 63, wr = wid >> 2, wc = wid & 3, fr = lane & 15, fq = lane >> 4;
    constexpr bool FP8 = Prob::FP8;
    constexpr int RB = FP8 ? GK : GK * 2;
    constexpr int nt = FP8 ? GK / 128 : GK / BK;
    unsigned voffA[2], voffB[2];
#pragma unroll
    for (int i = 0; i < 2; ++i) { int R, C; stage_rc(tid * 16 + i * 8192, R, C); const int Rb = Epi::PERM ? ((R & ~31) + perm32(R & 31)) : R;
        voffA[i] = (unsigned)(R * RB + C * 2); voffB[i] = (unsigned)(Rb * RB + C * 2); }
#define PG8_GATHER_LOAD(u, G_) do { int tid_ = tid; asm volatile("" : "+v"(tid_)); _Pragma("unroll") for (int i = 0; i < 2; ++i) { int R, C; stage_rc(tid_ * 16 + i * 8192, R, C); \
        G_[i] = P.a_rowoff(u, R); G_[2 + i] = P.a_rowoff(u, HALF + R); } } while (0)
#define PG8_GATHER_OFFS(G_, D0, D1) do { int tid_ = tid; asm volatile("" : "+v"(tid_)); _Pragma("unroll") for (int i = 0; i < 2; ++i) { int R, C; stage_rc(tid_ * 16 + i * 8192, R, C); \
        D0[i] = G_[i] * (unsigned)RB + (unsigned)(C * 2); D1[i] = G_[2 + i] * (unsigned)RB + (unsigned)(C * 2); } } while (0)
    constexpr size_t kstep = (size_t)(BK * 2);
    constexpr size_t hstep = (size_t)HALF * RB;
    const unsigned ldsw = (unsigned)wid * 1024u, lds0 = (unsigned)(uintptr_t)lds;
    const int aoff = lds_byte(wr * 64 + fr, fq * 8), boff = lds_byte(wc * 32 + fr, fq * 8);
#define PG8_SA(b, h) (((b) * 2 + (h)) * HTB)
#define PG8_SB(b, h) ((4 + (b) * 2 + (h)) * HTB)
#define PG8_STAGE(bufoff, gbase, voff) do { _Pragma("unroll") for (int _i = 0; _i < 2; ++_i) glds16s((const char*)(gbase), (voff)[_i], lds0 + (unsigned)(bufoff) + ldsw + (unsigned)(_i * 8192)); } while (0)
#define PG8_STAGE_A(b, h, gbase, VOG) do { if constexpr (Prob::GATHER) { PG8_STAGE(PG8_SA(b, h), (gbase), VOG); } else { PG8_STAGE(PG8_SA(b, h), (gbase) + (h) * hstep, voffA); } } while (0)
#define PG8_LDA(dst, b, h) do { _Pragma("unroll") for (int m = 0; m < 4; ++m) { if constexpr (FP8) { dst##8[m] = cat8(*(const PG8_LAS bf16x8*)(lds + PG8_SA(b, h) + aoff + m * 2048), *(const PG8_LAS bf16x8*)(lds + PG8_SA(b, h) + aoff + m * 2048 + 1024)); } \
        else { _Pragma("unroll") for (int k = 0; k < 2; ++k) dst[m][k] = *(const PG8_LAS bf16x8*)(lds + PG8_SA(b, h) + aoff + m * 2048 + k * 1024); } } } while (0)
#define PG8_LDB(dst, b, h) do { _Pragma("unroll") for (int n = 0; n < 2; ++n) { if constexpr (FP8) { dst##8[n] = cat8(*(const PG8_LAS bf16x8*)(lds + PG8_SB(b, h) + boff + n * 2048), *(const PG8_LAS bf16x8*)(lds + PG8_SB(b, h) + boff + n * 2048 + 1024)); } \
        else { _Pragma("unroll") for (int k = 0; k < 2; ++k) dst[n][k] = *(const PG8_LAS bf16x8*)(lds + PG8_SB(b, h) + boff + n * 2048 + k * 1024); } } } while (0)
#define PG8_MMA(ai, bj, At, Bt) do { __builtin_amdgcn_s_setprio(1); _Pragma("unroll") for (int m = 0; m < 4; ++m) _Pragma("unroll") for (int n = 0; n < 2; ++n) { \
        if constexpr (FP8) { asm volatile("v_mfma_f32_16x16x128_f8f6f4 %0, %1, %2, %0" : "+v"(acc[ai][bj][m][n]) : "v"(Bt##8[n]), "v"(At##8[m])); } \
        else { _Pragma("unroll") for (int k = 0; k < 2; ++k) acc[ai][bj][m][n] = __builtin_amdgcn_mfma_f32_16x16x32_bf16(Bt[n][k], At[m][k], acc[ai][bj][m][n], 0, 0, 0); } } \
        __builtin_amdgcn_s_setprio(0); } while (0)
#define PG8_WAIT_V(n) asm volatile("s_waitcnt vmcnt(" #n ")" ::: "memory")
#define PG8_WAIT_L(n) asm volatile("s_waitcnt lgkmcnt(" #n ")" ::: "memory")
#define PG8_BAR __builtin_amdgcn_s_barrier()
#define PG8_SCHED __builtin_amdgcn_sched_barrier(0)
    Unit cur, nxt; int ui = 0;
    if (!S.next(0, cur)) return;
    f32x4 acc[2][2][4][2];
#pragma unroll
    for (int a = 0; a < 2; ++a)
#pragma unroll
        for (int b = 0; b < 2; ++b)
#pragma unroll
            for (int m = 0; m < 4; ++m)
#pragma unroll
                for (int n = 0; n < 2; ++n) acc[a][b][m][n] = (f32x4){0.f, 0.f, 0.f, 0.f};
    bf16x8 At[4][2], B0[2][2], B1[2][2]; v8i_t At8[4], B08[2], B18[2]; typename Epi::Pre pre;
    const char* cA = P.a_tile(cur); const char* cB = P.b_tile(cur); Unit prv = cur;
    if constexpr (Sched::WAITS) S.a_ready(cur);
    unsigned vA0[2] = {0u, 0u}, vA1[2] = {0u, 0u}, vL1[2] = {0u, 0u};
    unsigned gix[4] = {0u, 0u, 0u, 0u};
    if constexpr (Prob::GATHER) { PG8_GATHER_LOAD(cur, gix); PG8_GATHER_OFFS(gix, vA0, vA1); vL1[0] = vA1[0]; vL1[1] = vA1[1]; }
    PG8_STAGE(PG8_SB(0, 0), cB, voffB); PG8_STAGE(PG8_SB(0, 1), cB + hstep, voffB); PG8_STAGE_A(0, 0, cA, vA0); PG8_STAGE_A(0, 1, cA, vA1);
    if (wr == 1) PG8_BAR;
    PG8_WAIT_V(2); PG8_BAR;
    PG8_STAGE(PG8_SB(1, 0), cB + kstep, voffB); PG8_STAGE_A(1, 0, cA + kstep, vA0); PG8_STAGE(PG8_SB(1, 1), cB + hstep + kstep, voffB);
    PG8_WAIT_V(6); PG8_BAR;
    for (;;) {
        const bool has_next = S.next(ui + 1, nxt);
        const char* nA = has_next ? P.a_tile(nxt) : cA; const char* nB = has_next ? P.b_tile(nxt) : cB;
        constexpr int NSEG = (Epi::MID > 0) ? 2 : 1;
#pragma unroll
        for (int seg = 0; seg < NSEG; ++seg) {
        if constexpr (Epi::MID > 0) { if (seg == 1) E.mid(acc, cur, wr, wc, fr, fq); }
        const int t_lo = (seg == 0) ? 0 : Epi::MID, t_hi = (Epi::MID > 0 && seg == 0) ? Epi::MID : nt;
#pragma unroll 1
        for (int t = t_lo; t < t_hi; t += 2) {
            const bool last = (t == nt - 2);
            const char* a1 = cA + (size_t)(t + 1) * kstep;
            const char* a2 = last ? nA : cA + (size_t)(t + 2) * kstep; const char* b2 = last ? nB : cB + (size_t)(t + 2) * kstep;
            const char* a3 = a2 + kstep; const char* b3 = b2 + kstep;
            if constexpr (Sched::WAITS) { if (last && has_next) S.a_ready(nxt); }
            if constexpr (Prob::GATHER) { if (has_next) { if (t == nt - 4) { PG8_GATHER_LOAD(nxt, gix); } if (last) { PG8_GATHER_OFFS(gix, vA0, vA1); } } }
            if constexpr (Epi::PREFETCH) { if (last) { int fr_ = fr, fq_ = fq; asm volatile("" : "+v"(fr_), "+v"(fq_)); E.prefetch(pre, cur, wr, wc, fr_, fq_); } }
            PG8_LDB(B0, 0, 0); PG8_LDB(B1, 0, 1); PG8_SCHED; PG8_LDA(At, 0, 0); PG8_STAGE_A(1, 1, a1, vL1);
            PG8_WAIT_V(8); PG8_WAIT_L(0); PG8_BAR; PG8_MMA(0, 0, At, B0); PG8_MMA(0, 1, At, B1); PG8_BAR; PG8_SCHED;
            PG8_LDA(At, 0, 1); PG8_STAGE(PG8_SB(0, 0), b2, voffB); PG8_STAGE(PG8_SB(0, 1), b2 + hstep, voffB); PG8_STAGE_A(0, 0, a2, vA0);
            PG8_WAIT_V(8); PG8_WAIT_L(0); PG8_BAR; PG8_MMA(1, 0, At, B0); PG8_MMA(1, 1, At, B1); PG8_BAR; PG8_SCHED;
            PG8_LDB(B0, 1, 0); PG8_LDB(B1, 1, 1); PG8_SCHED; PG8_LDA(At, 1, 0); PG8_STAGE_A(0, 1, a2, vA1);
            PG8_WAIT_V(8); PG8_WAIT_L(0); PG8_BAR; PG8_MMA(0, 0, At, B0); PG8_MMA(0, 1, At, B1); PG8_BAR; PG8_SCHED;
            PG8_LDA(At, 1, 1); PG8_STAGE(PG8_SB(1, 0), b3, voffB); PG8_STAGE(PG8_SB(1, 1), b3 + hstep, voffB); PG8_STAGE_A(1, 0, a3, vA0);
            PG8_WAIT_V(8); PG8_WAIT_L(0); PG8_BAR; PG8_MMA(1, 0, At, B0); PG8_MMA(1, 1, At, B1); PG8_BAR; PG8_SCHED;
        }
        }
        if constexpr (ALIGN_EPI) { if (wr == 0) PG8_BAR; }
        if constexpr (Sched::PUBLISHES) { if (ui > 0) { PG8_WAIT_V(0); S.publish(prv); } }
        if constexpr (FP8) asm volatile("s_nop 15\n\ts_nop 15" ::: "memory");
        { int fr_ = fr, fq_ = fq; asm volatile("" : "+v"(fr_), "+v"(fq_) :: "memory");
          E(acc, pre, cur, wr, wc, fr_, fq_); }
        if (!has_next) break;
#pragma unroll
        for (int a = 0; a < 2; ++a)
#pragma unroll
            for (int b = 0; b < 2; ++b)
#pragma unroll
                for (int m = 0; m < 4; ++m)
#pragma unroll
                    for (int n = 0; n < 2; ++n) acc[a][b][m][n] = (f32x4){0.f, 0.f, 0.f, 0.f};
        prv = cur; cur = nxt; cA = nA; cB = nB; ++ui;
        if constexpr (Prob::GATHER) { vL1[0] = vA1[0]; vL1[1] = vA1[1]; }
        if constexpr (ALIGN_EPI) { if (wr == 1) PG8_BAR; }
    }
    PG8_WAIT_V(0);
    if constexpr (Sched::PUBLISHES) S.publish(cur);
    if constexpr (!ALIGN_EPI) { if (wr == 0) PG8_BAR; }
    PG8_BAR;
#undef PG8_SA
#undef PG8_SB
#undef PG8_STAGE
#undef PG8_STAGE_A
#undef PG8_GATHER_OFFS
#undef PG8_GATHER_LOAD
#undef PG8_LDA
#undef PG8_LDB
#undef PG8_MMA
#undef PG8_WAIT_V
#undef PG8_WAIT_L
#undef PG8_BAR
#undef PG8_SCHED
}
}

constexpr int NWAVES = 8;
constexpr int N_LAUNCHES = MK_N_LAUNCHES;
constexpr int PER_PHASE = 9;

constexpr size_t MiB = 1u << 20;
constexpr size_t WS_CTL = 0, CTL_ZERO_BYTES = 1 * MiB;
constexpr size_t WS_WIN = 2 * MiB;
constexpr size_t WS_WMIX = 10 * MiB;
constexpr size_t WS_WOUT = 12 * MiB;
constexpr size_t WS_WRT = 14 * MiB;
constexpr size_t WS_WUP = 16 * MiB;
constexpr size_t WS_WDN = 144 * MiB;
constexpr size_t WS_H1 = 208 * MiB;
constexpr size_t WS_U = 240 * MiB;
constexpr size_t WS_Q = 256 * MiB;
constexpr size_t WS_KV = 272 * MiB;
constexpr size_t WS_GP = 280 * MiB;
constexpr size_t WS_GA = 312 * MiB;
constexpr size_t WS_ZA = 344 * MiB;
constexpr size_t WS_MIX = 376 * MiB;
constexpr size_t WS_X1 = 408 * MiB;
constexpr size_t WS_H2 = 472 * MiB;
constexpr size_t WS_LTOK = 504 * MiB;
constexpr size_t WS_LGATE = 506 * MiB;
constexpr size_t WS_LRSTD = 508 * MiB;
constexpr size_t WS_TOKE = 510 * MiB;
constexpr size_t WS_TOKP = 511 * MiB;
constexpr size_t WS_ACT = 512 * MiB;
constexpr size_t WS_Y = 656 * MiB;
constexpr size_t WS_H18 = 800 * MiB;
constexpr size_t WS_WIN8 = 816 * MiB;
constexpr size_t WS_END = 820 * MiB;
constexpr int CW_TMO = 0, CW_CODE = 1;
constexpr int CW_CNT = 1024;
constexpr int CW_BAR = 4096;
constexpr int CW_RTC = 32768;

constexpr int RING_OFF = 0, RING_BYTES = 131072;
constexpr int LDSCTL_OFF = RING_BYTES, MISC_OFF = LDSCTL_OFF + 320;
constexpr int TAB_OFF = MISC_OFF + 128;
constexpr int LDS_BYTES = 147456;
static_assert(TAB_OFF + (32 + 40 + NRT_MAX) * 4 <= LDS_BYTES, "LDS map");

#define GAS __attribute__((address_space(1)))
#define LAS __attribute__((address_space(3)))
typedef unsigned short bf16;
typedef unsigned v4u __attribute__((ext_vector_type(4)));
typedef unsigned v2u __attribute__((ext_vector_type(2)));
typedef float f32x4 __attribute__((ext_vector_type(4)));
typedef float f32x16 __attribute__((ext_vector_type(16)));
typedef short bf16x8 __attribute__((ext_vector_type(8)));
typedef GAS unsigned gu32;
#define RLX_AGENT __ATOMIC_RELAXED, __HIP_MEMORY_SCOPE_AGENT
#define LDS_WAIT() asm volatile("s_waitcnt lgkmcnt(0)" ::: "memory")
#define VM_WAIT() asm volatile("s_waitcnt vmcnt(0)" ::: "memory")
__device__ __forceinline__ unsigned f2bf(float f) { unsigned u = __builtin_bit_cast(unsigned, f); return (u + 0x7fffu + ((u >> 16) & 1u)) >> 16; }
__device__ __forceinline__ unsigned pk2(float lo, float hi) { return f2bf(lo) | (f2bf(hi) << 16); }
using pg8::cvt_pk_bf16; using pg8::bf_lo; using pg8::bf_hi;
typedef float f32x2_t __attribute__((ext_vector_type(2)));
typedef __bf16 bf16x2_t __attribute__((ext_vector_type(2)));
__device__ __forceinline__ unsigned cvtpk_s(float lo, float hi) { f32x2_t v = {lo, hi}; bf16x2_t b = __builtin_convertvector(v, bf16x2_t); return __builtin_bit_cast(unsigned, b); }

constexpr float W8_SCALE = 256.0f, W8_INV = 1.0f / 256.0f;
__device__ __forceinline__ float sat8(float x) { return __builtin_amdgcn_fmed3f(x, -448.f, 448.f); }
__device__ __forceinline__ unsigned pk4_fp8(float a, float b, float c, float d) { int w = 0; w = __builtin_amdgcn_cvt_pk_fp8_f32(sat8(a), sat8(b), w, false); w = __builtin_amdgcn_cvt_pk_fp8_f32(sat8(c), sat8(d), w, true); return (unsigned)w; }
#define XB_TMO      128
#define XB_XCNT(j)  (256  + 64 * (j))
#define XB_XSUB(j)  (1280 + 64 * (j))
#define XB_XGEN(j)  (2304 + 64 * (j))
#define XB_TOP      3328
#define XB_TOPGEN   3392
#define XCD_BAR_WORDS 3456
#define XB_LSUB(j)  (4096 + 64 * (j))
#define XB_LGEN(j)  (5120 + 64 * (j))
#define XB_SPIN_CAP (1u << 18)
__device__ __forceinline__ unsigned xb_ld(unsigned* p)              { return __hip_atomic_load(p, __ATOMIC_RELAXED, __HIP_MEMORY_SCOPE_AGENT); }
__device__ __forceinline__ unsigned xb_add(unsigned* p, unsigned v) { return __hip_atomic_fetch_add(p, v, __ATOMIC_RELAXED, __HIP_MEMORY_SCOPE_AGENT); }
__device__ __forceinline__ unsigned xb_xcc_id() { return (unsigned)__builtin_amdgcn_s_getreg((3 << 11) | 20) & 0xFu; }
#define XB_SPIN(cond, bar) do { unsigned _sp = 0; while (cond) { __builtin_amdgcn_s_sleep(1); \
    if ((++_sp & 255u) == 0u) { if (xb_ld(&(bar)[XB_TMO])) break; if (_sp > XB_SPIN_CAP) { atomicAdd(&(bar)[XB_TMO], 1u); break; } } } } while (0)
struct XcdBarrier { unsigned* bar; unsigned x; volatile LAS unsigned* st; };
__device__ __forceinline__ XcdBarrier xcd_barrier_post(unsigned* bar, volatile LAS unsigned* st) {
    XcdBarrier b; b.bar = bar; b.x = xb_xcc_id(); b.st = st;
    if (threadIdx.x == 0) st[2] = xb_add(&bar[XB_XCNT(b.x)], 1u);
    return b;
}
__device__ __forceinline__ void xcc_barrier(const XcdBarrier& b) {
    asm volatile("s_waitcnt vmcnt(0)" ::: "memory");
    __syncthreads();
    if (threadIdx.x == 0) {
        unsigned* bar = b.bar; const unsigned nloc = b.st[0];
        const unsigned old = xb_add(&bar[XB_LSUB(b.x)], 1u), gen = old / nloc;
        if (old + 1u == (gen + 1u) * nloc) xb_add(&bar[XB_LGEN(b.x)], 1u);
        else XB_SPIN(xb_ld(&bar[XB_LGEN(b.x)]) == gen, bar);
        __builtin_amdgcn_fence(__ATOMIC_ACQUIRE, "agent");
        asm volatile("s_waitcnt vmcnt(0)" ::: "memory");
    }
    __syncthreads();
}
__device__ __forceinline__ int xcc_layout(const XcdBarrier& b, int& rank, int& dense) {
    unsigned* bar = b.bar; unsigned nx = 0u, lower = 0u; bool even = true; const unsigned mine = xb_ld(&bar[XB_XCNT(b.x)]);
#pragma unroll
    for (unsigned j = 0; j < 16; ++j) { const unsigned c = xb_ld(&bar[XB_XCNT(j)]); if (c) { ++nx; if (j < b.x) ++lower; if (c != mine) even = false; } }
    rank = (int)b.st[2]; dense = (int)lower;
    return (even && nx == 8u && mine == 32u && rank < 32) ? 1 : 0;
}
__device__ __forceinline__ void xcd_barrier_complete(unsigned* bar, unsigned x, unsigned& nloc, unsigned& nx) {
    const unsigned G = gridDim.x * gridDim.y * gridDim.z;
    unsigned sum, cnt, mine, sp = 0u;
    for (;;) {
        sum = 0u; cnt = 0u; mine = 0u;
#pragma unroll
        for (unsigned j = 0; j < 16; ++j) { const unsigned c = xb_ld(&bar[XB_XCNT(j)]); sum += c; cnt += (c > 0u) ? 1u : 0u; mine = (j == x) ? c : mine; }
        if (sum == G) break;
        __builtin_amdgcn_s_sleep(1);
        if ((++sp & 255u) == 0u) { if (xb_ld(&bar[XB_TMO])) break; if (sp > XB_SPIN_CAP) { atomicAdd(&bar[XB_TMO], 1u); break; } }
    }
    nloc = mine > 0u ? mine : 1u; nx = cnt > 0u ? cnt : 1u;
}
__device__ __forceinline__ void xcd_barrier(const XcdBarrier& b) {
    asm volatile("s_waitcnt vmcnt(0)" ::: "memory");
    __syncthreads();
    if (threadIdx.x == 0) {
        unsigned* bar = b.bar;
        __builtin_amdgcn_s_waitcnt(0);
        unsigned nloc = b.st[0], nx = b.st[1];
        if (nloc == 0u) { xcd_barrier_complete(bar, b.x, nloc, nx); b.st[0] = nloc; b.st[1] = nx; }
        const unsigned old = xb_add(&bar[XB_XSUB(b.x)], 1u);
        const unsigned gen = old / nloc;
        if (old + 1u == (gen + 1u) * nloc) {
            __builtin_amdgcn_fence(__ATOMIC_RELEASE, "agent");
            asm volatile("s_waitcnt vmcnt(0)" ::: "memory");
            const unsigned og = xb_add(&bar[XB_TOP], 1u);
            const unsigned tg = og / nx;
            if (og + 1u == (tg + 1u) * nx) xb_add(&bar[XB_TOPGEN], 1u);
            else XB_SPIN(xb_ld(&bar[XB_TOPGEN]) == tg, bar);
            __builtin_amdgcn_fence(__ATOMIC_ACQUIRE, "agent");
            xb_add(&bar[XB_XGEN(b.x)], 1u);
            asm volatile("s_waitcnt vmcnt(0)" ::: "memory");
        } else {
            XB_SPIN(xb_ld(&bar[XB_XGEN(b.x)]) == gen, bar);
            __builtin_amdgcn_fence(__ATOMIC_ACQUIRE, "agent");
            asm volatile("s_waitcnt vmcnt(0)" ::: "memory");
        }
    }
    __syncthreads();
}

struct Frame {
    LAS unsigned char* lds;
    volatile LAS unsigned* MISC;
    LAS int* TAB;
    gu32* ctl;
    int tid, lane, wave;
    int vcu, G, bx, xloc;
    const float *x, *norm1_g, *w_in, *pool_w, *pool_scale, *w_pool_proj, *sinks, *w_attn_proj, *w_out, *norm2_g, *w_router, *b_router, *w_up, *b_up, *w_down, *b_down, *rel_bias, *final_g;
    float* out;
    unsigned char* ws;
};
#define WSP(T_, off) ((T_*)(F.ws + (off)))

__device__ __forceinline__ float wave_sum(float v) {
#pragma unroll
    for (int o = 1; o < 64; o <<= 1) v += __shfl_xor(v, o);
    return v;
}

template <int MAP  >
__device__ __forceinline__ void p0_transpose_item(const float* W, int N, bf16* WT, int ldt, int koff, LAS float* scr, int item, int lane) {
    const int nblk = N / 32, kb = item / nblk, nb = item % nblk, k0 = 64 * kb, n0 = 32 * nb;
    float v[32];
#pragma unroll
    for (int i = 0; i < 32; ++i) { const int kk = 2 * i + (lane >> 5); v[i] = W[(size_t)(k0 + kk) * N + n0 + (lane & 31)]; }
#pragma unroll
    for (int i = 0; i < 32; ++i) { const int kk = 2 * i + (lane >> 5); scr[kk * 33 + (lane & 31)] = v[i]; }
    LDS_WAIT(); asm volatile("" ::: "memory");
    const int c = lane & 7;
#pragma unroll
    for (int j = 0; j < 4; ++j) { const int n = (lane >> 3) + 8 * j; const LAS float* s = scr + (8 * c) * 33 + n;
        v4u o; o.x = pk2(s[0 * 33], s[1 * 33]); o.y = pk2(s[2 * 33], s[3 * 33]); o.z = pk2(s[4 * 33], s[5 * 33]); o.w = pk2(s[6 * 33], s[7 * 33]);
        int nn = n0 + n;
        if (MAP == 1) { const int pn = nn >> 8, rem = nn & 255; nn = (pn << 8) + ((rem & 1) << 7) + (rem >> 1); }
        *(GAS v4u*)(WT + (size_t)nn * ldt + koff + k0 + 8 * c) = o; }
    LDS_WAIT(); asm volatile("" ::: "memory");
}
struct Fp8Src { const float* W; int N; unsigned char* WT; int item; const float* g; int ld; };
__device__ __forceinline__ void fp8_tile_load(Frame& F, const Fp8Src& S, f32x4 (&v)[16]) {
    const int nblk = S.N / 256, kb = S.item / nblk, nb = S.item % nblk;
    const float* src = S.W + (size_t)(128 * kb + 16 * F.wave) * S.ld + 256 * nb + 4 * F.lane;
#pragma unroll
    for (int i = 0; i < 16; ++i) v[i] = __builtin_nontemporal_load((const GAS f32x4*)(src + (size_t)i * S.ld));
}
__device__ __forceinline__ void fp8_tile_pack(Frame& F, const Fp8Src& S, const f32x4 (&v)[16], v4u (&o)[4]) {
    float sc[16]; const int kr = 128 * (S.item / (S.N / 256)) + 16 * F.wave;
#pragma unroll
    for (int i = 0; i < 16; ++i) sc[i] = S.g ? S.g[kr + i] * W8_SCALE : W8_SCALE;
#pragma unroll
    for (int j = 0; j < 4; ++j)
#pragma unroll
        for (int q = 0; q < 4; ++q) o[j][q] = pk4_fp8(v[4 * q][j] * sc[4 * q], v[4 * q + 1][j] * sc[4 * q + 1], v[4 * q + 2][j] * sc[4 * q + 2], v[4 * q + 3][j] * sc[4 * q + 3]);
}
template <int MAP>
__device__ __forceinline__ void fp8_tile_store(Frame& F, const Fp8Src& S, const v4u (&o)[4]) {
    const int nblk = S.N / 256, kb = S.item / nblk, nb = S.item % nblk, k0 = 128 * kb, n0 = 256 * nb, lane = F.lane, w = F.wave;
    LAS unsigned char* tile = F.lds + RING_OFF;
    __syncthreads();
#pragma unroll
    for (int j = 0; j < 4; ++j) { const int row = 4 * lane + j; *(LAS v4u*)(tile + row * 128 + ((w ^ (lane & 7)) << 4)) = o[j]; }
    __syncthreads();
#pragma unroll
    for (int i = 0; i < 4; ++i) { const int row = (F.tid >> 3) + 64 * i, c = F.tid & 7; const v4u t = *(const LAS v4u*)(tile + row * 128 + ((c ^ ((row >> 2) & 7)) << 4));
        int nn = n0 + row; if (MAP == 1) { const int pn = nn >> 8, rem = nn & 255; nn = (pn << 8) + ((rem & 1) << 7) + (rem >> 1); }
        *(GAS v4u*)(S.WT + (size_t)nn * 1024 + k0 + 16 * c) = t; }
}
template <int WHICH>
__device__ __forceinline__ void convert_moe_w(Frame& F, int lo, int hi, int first, int nblk) {
    constexpr int NW = WHICH ? 2048 : DM, I1 = (DM / 128) * (NW / 256);
    const float* Wsrc = WHICH ? F.w_up : F.w_down; unsigned char* Wdst = WHICH ? WSP(unsigned char, WS_WUP) : WSP(unsigned char, WS_WDN);
    f32x4 v[16]; int it = lo + first;
    Fp8Src cur{nullptr, NW, nullptr, 0, WHICH ? F.norm2_g : nullptr, NW};
    if (it < hi) { const int e = it / I1; cur.W = Wsrc + (size_t)e * DM * NW; cur.WT = Wdst + (size_t)e * NW * DM; cur.item = it % I1; fp8_tile_load(F, cur, v); }
    while (it < hi) {
        v4u o[4]; fp8_tile_pack(F, cur, v, o);
        const int nx = it + nblk; Fp8Src nxt = cur;
        if (nx < hi) { const int e = nx / I1; nxt.W = Wsrc + (size_t)e * DM * NW; nxt.WT = Wdst + (size_t)e * NW * DM; nxt.item = nx % I1; fp8_tile_load(F, nxt, v); }
        fp8_tile_store<WHICH>(F, cur, o);
        cur = nxt; it = nx;
    }
    __syncthreads();
}
#ifndef DN_SPLIT
#define DN_SPLIT 384
#endif
__device__ __forceinline__ void convert_win8(Frame& F) {
    f32x4 v[16];
    for (int it = F.vcu; it < 64; it += F.G) { Fp8Src S{F.w_in + 1280, 2048, WSP(unsigned char, WS_WIN8), it, nullptr, INW};
        fp8_tile_load(F, S, v); v4u o[4]; fp8_tile_pack(F, S, v, o); fp8_tile_store<0>(F, S, o); }
    __syncthreads();
}
__device__ __forceinline__ void p0_prologue(Frame& F) {
    LAS float* scr = (LAS float*)(F.lds + RING_OFF + F.wave * 16384);
    const int gw = F.vcu * NWAVES + F.wave, NGW = F.G * NWAVES, lane = F.lane;
    bf16* Win_t = WSP(bf16, WS_WIN); bf16* Wmix_t = WSP(bf16, WS_WMIX); bf16* Wout_t = WSP(bf16, WS_WOUT); bf16* Wrt = WSP(bf16, WS_WRT);
    unsigned char* Wup_t = WSP(unsigned char, WS_WUP); bf16* H1 = WSP(bf16, WS_H1);
    if (F.wave < 4) for (int it = F.vcu * 4 + F.wave; it < 16 * 64; it += F.G * 4) {
        const int nb = it & 15, k8 = it >> 4, n = nb * 64 + lane, k0 = k8 * 8, g = k0 >> 7, kk0 = k0 & 127;
        float a[8];
#pragma unroll
        for (int i = 0; i < 8; ++i) a[i] = 0.f;
        const float* pw = F.pool_w + ((size_t)g * 128 + kk0) * 128; const float* wp = F.w_pool_proj + (size_t)(g * 128) * DM + n; const float* ps = F.pool_scale + g * 128;
#pragma unroll 1
        for (int j0 = 0; j0 < 128; j0 += 16) {
            float b[16];
#pragma unroll
            for (int j = 0; j < 16; ++j) b[j] = wp[(size_t)(j0 + j) * DM];
#pragma unroll
            for (int j = 0; j < 16; ++j) { const float bs = b[j] * ps[j0 + j];
#pragma unroll
                for (int i = 0; i < 8; ++i) a[i] += pw[i * 128 + j0 + j] * bs; }
        }
        v4u o; o.x = pk2(a[0], a[1]); o.y = pk2(a[2], a[3]); o.z = pk2(a[4], a[5]); o.w = pk2(a[6], a[7]);
        *(GAS v4u*)(Wmix_t + (size_t)n * DM + k0) = o;
    }
    constexpr int I_IN = (DM / 64) * (INW / 32), I_OUT = (DM / 64) * (DM / 32), I_AP = (512 / 64) * (DM / 32);
    constexpr int NITEMS = I_IN + I_OUT + I_AP;
    for (int it = gw; it < NITEMS; it += NGW) {
        int r = it;
        if (r < I_IN) { p0_transpose_item<0>(F.w_in, INW, Win_t, DM, 0, scr, r, lane); continue; } r -= I_IN;
        if (r < I_OUT) { p0_transpose_item<0>(F.w_out, DM, Wout_t, DM, 0, scr, r, lane); continue; } r -= I_OUT;
        p0_transpose_item<0>(F.w_attn_proj, DM, Wmix_t, DM, 512, scr, r, lane);
    }
    {
        const GAS f32x4* gp = (const GAS f32x4*)F.norm1_g + lane; f32x4 g[4];
#pragma unroll
        for (int j = 0; j < 4; ++j) g[j] = gp[64 * j];
        for (int m = gw; m < T_TOK; m += NGW) {
            const GAS f32x4* xr = (const GAS f32x4*)(F.x + (size_t)m * DM) + lane; f32x4 v[4]; float s2 = 0.f;
#pragma unroll
            for (int j = 0; j < 4; ++j) { v[j] = __builtin_nontemporal_load(xr + 64 * j); s2 += (v[j].x * v[j].x + v[j].y * v[j].y) + (v[j].z * v[j].z + v[j].w * v[j].w); }
            const float rstd = 1.f / sqrtf(wave_sum(s2) * (1.f / DM) + RMS_EPS);
            GAS unsigned long long* o8 = (GAS unsigned long long*)(H1 + (size_t)m * DM) + lane; GAS unsigned* o4 = (GAS unsigned*)(WSP(unsigned char, WS_H18) + (size_t)m * DM) + lane;
#pragma unroll
            for (int j = 0; j < 4; ++j) { const float h0 = v[j].x * rstd * g[j].x, h1v = v[j].y * rstd * g[j].y, h2 = v[j].z * rstd * g[j].z, h3 = v[j].w * rstd * g[j].w;
                o8[64 * j] = (unsigned long long)pk2(h0, h1v) | ((unsigned long long)pk2(h2, h3) << 32); o4[64 * j] = pk4_fp8(h0, h1v, h2, h3); }
        }
    }
    convert_win8(F);
    for (int it = gw * 64 + lane; it < 32 * 128; it += NGW * 64) {
        const int e = it & 31, k0 = (it >> 5) * 8; unsigned hi[4], lo[4];
#pragma unroll
        for (int i = 0; i < 4; ++i) { const float v0 = F.w_router[(size_t)(k0 + 2 * i) * NEXP + e] * F.norm2_g[k0 + 2 * i], v1 = F.w_router[(size_t)(k0 + 2 * i + 1) * NEXP + e] * F.norm2_g[k0 + 2 * i + 1];
            hi[i] = pk2(v0, v1); lo[i] = pk2(v0 - bf_lo(hi[i]), v1 - bf_hi(hi[i])); }
        *(GAS v4u*)(Wrt + (size_t)e * DM + k0) = (v4u){hi[0], hi[1], hi[2], hi[3]};
        *(GAS v4u*)(Wrt + (size_t)(NEXP + e) * DM + k0) = (v4u){lo[0], lo[1], lo[2], lo[3]};
    }
}

struct ProbDense {
    static constexpr bool GATHER = false, FP8 = false;
    const char* A; const char* Bt;
    __device__ __forceinline__ const char* a_tile(const pg8::Unit& u) const { return A + (size_t)u.pm * (256 * 2048); }
    __device__ __forceinline__ const char* b_tile(const pg8::Unit& u) const { return Bt + (size_t)u.pn * (256 * 2048); }
    __device__ __forceinline__ unsigned a_rowoff(const pg8::Unit&, int) const { return 0u; }
};
struct ProbDense8 {
    static constexpr bool GATHER = false, FP8 = true;
    const char* A; const char* Bt;
    __device__ __forceinline__ const char* a_tile(const pg8::Unit& u) const { return A + (size_t)u.pm * (256 * 1024); }
    __device__ __forceinline__ const char* b_tile(const pg8::Unit& u) const { return Bt + (size_t)u.pn * (256 * 1024); }
    __device__ __forceinline__ unsigned a_rowoff(const pg8::Unit&, int) const { return 0u; }
};
struct P1Order {
    static constexpr bool WAITS = false, PUBLISHES = false;
    int x, r, fp8;
    __host__ __device__ bool next(int i, pg8::Unit& u) const {
        int j;
        if (!fp8) { if (i == 0) j = r; else if (i == 1 && r < 8) j = 32 + r; else return false; }
        else { if (r < 8) { if (i) return false; j = r; } else { j = r + 24 * i; if (i > 2 || j >= 64) return false; } }
        u.pm = 8 * x + (j & 7); u.pn = j >> 3; return true;
    }
};
struct ProbUp {
    static constexpr bool GATHER = true, FP8 = true;
    const char* A; const char* Bt; const int* ltok; const LAS int* TAB;
    __device__ __forceinline__ const char* a_tile(const pg8::Unit&) const { return A; }
    __device__ __forceinline__ const char* b_tile(const pg8::Unit& u) const { const int e = __builtin_amdgcn_readfirstlane(TAB[72 + u.pm]); return Bt + ((size_t)e * 2048 + (size_t)u.pn * 256) * 1024; }
    __device__ __forceinline__ unsigned a_rowoff(const pg8::Unit& u, int r) const {
        const int e = __builtin_amdgcn_readfirstlane(TAB[72 + u.pm]), pos = (u.pm - __builtin_amdgcn_readfirstlane(TAB[32 + e])) * 256 + r, cnt = __builtin_amdgcn_readfirstlane(TAB[e]);
        return (unsigned)ltok[e * CAP + (pos < cnt ? pos : 0)]; }
};
struct ProbDown {
    static constexpr bool GATHER = false, FP8 = true;
    const char* A; const char* Bt; const LAS int* TAB;
    __device__ __forceinline__ const char* a_tile(const pg8::Unit& u) const { return A + (size_t)u.pm * (256 * 1024); }
    __device__ __forceinline__ const char* b_tile(const pg8::Unit& u) const { const int e = __builtin_amdgcn_readfirstlane(TAB[72 + u.pm]); return Bt + ((size_t)e * 1024 + (size_t)u.pn * 256) * 1024; }
    __device__ __forceinline__ unsigned a_rowoff(const pg8::Unit&, int) const { return 0u; }
};

using pg8::f32x2; using pg8::u32x4;
struct NoPre {};
struct EpiInProj {
    static constexpr bool PERM = true, PREFETCH = false; static constexpr int MID = 0; typedef NoPre Pre;
    bf16 *U, *Q, *KV, *GP, *GA;
    __device__ __forceinline__ void mid(pg8::f32x4 (&)[2][2][4][2], const pg8::Unit&, int, int, int, int) const {}
    __device__ __forceinline__ void operator()(const pg8::f32x4 (&acc)[2][2][4][2], const NoPre&, const pg8::Unit& u, int wr, int wc, int fr, int fq) const {
        bf16* base; int ldc; float sc = 1.f; const int pn = u.pn;
        if (pn < 2) { base = U + pn * 256; ldc = 512; } else if (pn < 4) { base = Q + (pn - 2) * 256; ldc = 512; sc = 0.125f; } else if (pn == 4) { base = KV; ldc = 256; }
        else if (pn < 9) { base = GP + (pn - 5) * 256; ldc = 1024; } else { base = GA + (pn - 9) * 256; ldc = 1024; }
        const int row0 = u.pm * 256 + wr * 64 + fr, col0 = wc * 32 + 8 * fq;
#pragma unroll
        for (int ai = 0; ai < 2; ++ai)
#pragma unroll
            for (int m = 0; m < 4; ++m) { bf16* rowp = base + (size_t)(row0 + ai * 128 + m * 16) * ldc + col0;
#pragma unroll
                for (int bj = 0; bj < 2; ++bj) { const pg8::f32x4 v0 = acc[ai][bj][m][0] * sc, v1 = acc[ai][bj][m][1] * sc;
                    u32x4 w; w.x = cvt_pk_bf16(v0[0], v0[1]); w.y = cvt_pk_bf16(v0[2], v0[3]); w.z = cvt_pk_bf16(v1[0], v1[1]); w.w = cvt_pk_bf16(v1[2], v1[3]);
                    *(u32x4*)(rowp + bj * 128) = w; } }
    }
};
struct EpiGate8 {
    static constexpr bool PERM = true, PREFETCH = false; static constexpr int MID = 0; typedef NoPre Pre;
    unsigned char *GP, *GA;
    __device__ __forceinline__ void mid(pg8::f32x4 (&)[2][2][4][2], const pg8::Unit&, int, int, int, int) const {}
    __device__ __forceinline__ void operator()(const pg8::f32x4 (&acc)[2][2][4][2], const NoPre&, const pg8::Unit& u, int wr, int wc, int fr, int fq) const {
        unsigned char* base = (u.pn < 4) ? GP + u.pn * 256 : GA + (u.pn - 4) * 256;
        const int row0 = u.pm * 256 + wr * 64 + fr, col0 = wc * 32 + 8 * fq;
#pragma unroll
        for (int ai = 0; ai < 2; ++ai)
#pragma unroll
            for (int m = 0; m < 4; ++m) { unsigned char* rowp = base + (size_t)(row0 + ai * 128 + m * 16) * 1024 + col0;
#pragma unroll
                for (int bj = 0; bj < 2; ++bj) { const pg8::f32x4 v0 = acc[ai][bj][m][0] * W8_INV, v1 = acc[ai][bj][m][1] * W8_INV;
                    v2u w; w.x = pk4_fp8(v0[0], v0[1], v0[2], v0[3]); w.y = pk4_fp8(v1[0], v1[1], v1[2], v1[3]);
                    *(v2u*)(rowp + bj * 128) = w; } }
    }
};
__device__ __forceinline__ float clampf(float x, float lo, float hi) { return fminf(fmaxf(x, lo), hi); }
__device__ __forceinline__ float en(float x) { return __builtin_amdgcn_exp2f(-LOG2E * clampf(x, -80.f, 80.f)); }
struct EpiMix {
    static constexpr bool PERM = true, PREFETCH = false; static constexpr int MID = 8; typedef NoPre Pre;
    const unsigned char *GP, *GA; bf16* MIX;
    static __device__ __forceinline__ void dec8(v2u w, float (&x)[8]) {
        const f32x2_t a = __builtin_amdgcn_cvt_pk_f32_fp8((int)w.x, false), b = __builtin_amdgcn_cvt_pk_f32_fp8((int)w.x, true), c = __builtin_amdgcn_cvt_pk_f32_fp8((int)w.y, false), d = __builtin_amdgcn_cvt_pk_f32_fp8((int)w.y, true);
        x[0] = a[0]; x[1] = a[1]; x[2] = b[0]; x[3] = b[1]; x[4] = c[0]; x[5] = c[1]; x[6] = d[0]; x[7] = d[1]; }
    __device__ __forceinline__ void mid(pg8::f32x4 (&acc)[2][2][4][2], const pg8::Unit& u, int wr, int wc, int fr, int fq) const {
        const unsigned off0 = (unsigned)(u.pm * 256 + wr * 64 + fr) * 1024u + (unsigned)(u.pn * 256 + wc * 32 + 8 * fq);
#pragma unroll
        for (int ai = 0; ai < 2; ++ai) {
            v2u p[4][2], a[4][2];
#pragma unroll
            for (int m = 0; m < 4; ++m)
#pragma unroll
                for (int bj = 0; bj < 2; ++bj) { const unsigned off = off0 + (unsigned)((ai * 128 + m * 16) * 1024 + bj * 128); p[m][bj] = *(const v2u*)(GP + off); a[m][bj] = *(const v2u*)(GA + off); }
#pragma unroll
            for (int m = 0; m < 4; ++m)
#pragma unroll
                for (int bj = 0; bj < 2; ++bj) { float xp[8], xa[8]; dec8(p[m][bj], xp); dec8(a[m][bj], xa);
#pragma unroll
                    for (int c = 0; c < 8; ++c) acc[ai][bj][m][c >> 2][c & 3] *= (1.f + en(xa[c])) * __builtin_amdgcn_rcpf(1.f + en(xp[c]));
                    asm volatile("" : "+v"(acc[ai][bj][m][0]), "+v"(acc[ai][bj][m][1])); }
            asm volatile("" ::: "memory");
        }
    }
    __device__ __forceinline__ void operator()(const pg8::f32x4 (&acc)[2][2][4][2], const NoPre&, const pg8::Unit& u, int wr, int wc, int fr, int fq) const {
        const unsigned off0 = (unsigned)(u.pm * 256 + wr * 64 + fr) * 1024u + (unsigned)(u.pn * 256 + wc * 32 + 8 * fq);
        v2u a[2][4][2];
#pragma unroll
        for (int ai = 0; ai < 2; ++ai)
#pragma unroll
            for (int m = 0; m < 4; ++m)
#pragma unroll
                for (int bj = 0; bj < 2; ++bj) a[ai][m][bj] = *(const v2u*)(GA + off0 + (unsigned)((ai * 128 + m * 16) * 1024 + bj * 128));
#pragma unroll
        for (int ai = 0; ai < 2; ++ai)
#pragma unroll
            for (int m = 0; m < 4; ++m)
#pragma unroll
                for (int bj = 0; bj < 2; ++bj) { float xa[8], sg[8]; dec8(a[ai][m][bj], xa);
#pragma unroll
                    for (int c = 0; c < 8; ++c) sg[c] = __builtin_amdgcn_rcpf(1.f + en(xa[c]));
                    const pg8::f32x4 v0 = acc[ai][bj][m][0], v1 = acc[ai][bj][m][1];
                    u32x4 w; w.x = cvtpk_s(v0[0] * sg[0], v0[1] * sg[1]); w.y = cvtpk_s(v0[2] * sg[2], v0[3] * sg[3]); w.z = cvtpk_s(v1[0] * sg[4], v1[1] * sg[5]); w.w = cvtpk_s(v1[2] * sg[6], v1[3] * sg[7]);
                    *(u32x4*)(MIX + off0 + (unsigned)((ai * 128 + m * 16) * 1024 + bj * 128)) = w; }
    }
};
struct EpiOut {
    static constexpr bool PERM = true, PREFETCH = false; static constexpr int MID = 0; typedef NoPre Pre;
    const float* X; bf16* X1;
    __device__ __forceinline__ void mid(pg8::f32x4 (&)[2][2][4][2], const pg8::Unit&, int, int, int, int) const {}
    __device__ __forceinline__ void operator()(const pg8::f32x4 (&acc)[2][2][4][2], const NoPre&, const pg8::Unit& u, int wr, int wc, int fr, int fq) const {
        const unsigned off0 = (unsigned)(u.pm * 256 + wr * 64 + fr) * 1024u + (unsigned)(u.pn * 256 + wc * 32 + 8 * fq);
#pragma unroll
        for (int ai = 0; ai < 2; ++ai) {
            pg8::f32x4 xv[4][2][2];
#pragma unroll
            for (int m = 0; m < 4; ++m)
#pragma unroll
                for (int bj = 0; bj < 2; ++bj)
#pragma unroll
                    for (int n = 0; n < 2; ++n) xv[m][bj][n] = *(const pg8::f32x4*)(X + off0 + (unsigned)((ai * 128 + m * 16) * 1024 + bj * 128 + n * 4));
#pragma unroll
            for (int m = 0; m < 4; ++m)
#pragma unroll
                for (int bj = 0; bj < 2; ++bj) { const pg8::f32x4 v0 = xv[m][bj][0] + acc[ai][bj][m][0], v1 = xv[m][bj][1] + acc[ai][bj][m][1];
                    u32x4 w; w.x = cvtpk_s(v0[0], v0[1]); w.y = cvtpk_s(v0[2], v0[3]); w.z = cvtpk_s(v1[0], v1[1]); w.w = cvtpk_s(v1[2], v1[3]);
                    *(u32x4*)(X1 + off0 + (unsigned)((ai * 128 + m * 16) * 1024 + bj * 128)) = w; }
            asm volatile("" ::: "memory");
        }
    }
};
struct EpiUp {
    static constexpr bool PERM = true, PREFETCH = true; static constexpr int MID = 0;
    struct Pre { pg8::f32x4 bq[4]; float rsv[2][4]; };
    const float* b_up; const float* lrstd; unsigned char* ACT; const LAS int* TAB;
    __device__ __forceinline__ void prefetch(Pre& p, const pg8::Unit& u, int wr, int wc, int fr, int fq) const {
        const int e = __builtin_amdgcn_readfirstlane(TAB[72 + u.pm]), pos0 = (u.pm - __builtin_amdgcn_readfirstlane(TAB[32 + e])) * 256, cnt = __builtin_amdgcn_readfirstlane(TAB[e]);
        const int rl0 = wr * 64 + fr, cc0 = wc * 32 + 8 * fq;
        const float* bp = b_up + (size_t)e * 2048 + 2 * (128 * u.pn + cc0);
#pragma unroll
        for (int q = 0; q < 4; ++q) p.bq[q] = *(const pg8::f32x4*)(bp + 4 * q);
#pragma unroll
        for (int ai = 0; ai < 2; ++ai)
#pragma unroll
            for (int m = 0; m < 4; ++m) { const int pos = pos0 + rl0 + ai * 128 + m * 16; p.rsv[ai][m] = lrstd[e * CAP + (pos < cnt ? pos : 0)]; }
    }
    __device__ __forceinline__ void mid(pg8::f32x4 (&)[2][2][4][2], const pg8::Unit&, int, int, int, int) const {}
    __device__ __forceinline__ void operator()(const pg8::f32x4 (&acc)[2][2][4][2], const Pre& pre, const pg8::Unit& u, int wr, int wc, int fr, int fq) const {
        const int e = __builtin_amdgcn_readfirstlane(TAB[72 + u.pm]), pos0 = (u.pm - __builtin_amdgcn_readfirstlane(TAB[32 + e])) * 256, cnt = __builtin_amdgcn_readfirstlane(TAB[e]);
        const int rl0 = wr * 64 + fr, cc0 = wc * 32 + 8 * fq;
        const pg8::f32x4 (&bq)[4] = pre.bq; float rsv[2][4];
#pragma unroll
        for (int ai = 0; ai < 2; ++ai)
#pragma unroll
            for (int m = 0; m < 4; ++m) rsv[ai][m] = (pos0 + rl0 + ai * 128 + m * 16) < cnt ? pre.rsv[ai][m] * W8_INV : 0.f;
        f32x2 bg[4], bl[4];
#pragma unroll
        for (int q = 0; q < 4; ++q) { bg[q] = (f32x2){bq[q][0], bq[q][2]}; bl[q] = (f32x2){bq[q][1], bq[q][3]}; }
        constexpr float KS = -1.702f * LOG2E;
#pragma unroll
        for (int ai = 0; ai < 2; ++ai)
#pragma unroll
            for (int m = 0; m < 4; ++m) { const int rl = rl0 + ai * 128 + m * 16; const float rs = rsv[ai][m]; const f32x2 rs2 = (f32x2){rs, rs};
                unsigned pk[4];
#pragma unroll
                for (int p = 0; p < 4; ++p) { const int n = p >> 1, i = (p & 1) * 2;
                    f32x2 g = (f32x2){acc[ai][0][m][n][i], acc[ai][0][m][n][i + 1]} * rs2 + bg[p], l = (f32x2){acc[ai][1][m][n][i], acc[ai][1][m][n][i + 1]} * rs2 + bl[p];
                    g.x = fminf(g.x, 7.0f); g.y = fminf(g.y, 7.0f); l.x = __builtin_amdgcn_fmed3f(l.x, -7.0f, 7.0f); l.y = __builtin_amdgcn_fmed3f(l.y, -7.0f, 7.0f);
                    const f32x2 t = g * KS; f32x2 ex; ex.x = __builtin_amdgcn_exp2f(t.x); ex.y = __builtin_amdgcn_exp2f(t.y);
                    const f32x2 d = ex + 1.0f; f32x2 sg; sg.x = __builtin_amdgcn_rcpf(d.x); sg.y = __builtin_amdgcn_rcpf(d.y);
                    const f32x2 o = g * sg, r = o * l + o;
                    pk[p] = (unsigned)__builtin_amdgcn_cvt_pk_fp8_f32(r.x, r.y, 0, false) & 0xffffu; }
                v2u w; w.x = pk[0] | (pk[1] << 16); w.y = pk[2] | (pk[3] << 16);
                *(v2u*)(ACT + (size_t)(u.pm * 256 + rl) * 1024 + 128 * u.pn + cc0) = w; }
    }
};
struct EpiDown {
    static constexpr bool PERM = true, PREFETCH = true; static constexpr int MID = 0;
    struct Pre { pg8::f32x4 bv[2][2]; float gtv[2][4]; };
    const float* b_dn; const float* lgate; unsigned char* Y; const LAS int* TAB;
    __device__ __forceinline__ void prefetch(Pre& p, const pg8::Unit& u, int wr, int wc, int fr, int fq) const {
        const int e = __builtin_amdgcn_readfirstlane(TAB[72 + u.pm]), pos0 = (u.pm - __builtin_amdgcn_readfirstlane(TAB[32 + e])) * 256, cnt = __builtin_amdgcn_readfirstlane(TAB[e]);
        const int rl0 = wr * 64 + fr, col0 = u.pn * 256 + wc * 32 + 8 * fq;
#pragma unroll
        for (int bj = 0; bj < 2; ++bj)
#pragma unroll
            for (int n = 0; n < 2; ++n) p.bv[bj][n] = *(const pg8::f32x4*)(b_dn + (size_t)e * 1024 + col0 + bj * 128 + 4 * n);
#pragma unroll
        for (int ai = 0; ai < 2; ++ai)
#pragma unroll
            for (int m = 0; m < 4; ++m) { const int pos = pos0 + rl0 + ai * 128 + m * 16; p.gtv[ai][m] = lgate[e * CAP + (pos < cnt ? pos : 0)]; }
    }
    __device__ __forceinline__ void mid(pg8::f32x4 (&)[2][2][4][2], const pg8::Unit&, int, int, int, int) const {}
    __device__ __forceinline__ void operator()(const pg8::f32x4 (&acc)[2][2][4][2], const Pre& pre, const pg8::Unit& u, int wr, int wc, int fr, int fq) const {
        const int e = __builtin_amdgcn_readfirstlane(TAB[72 + u.pm]), pos0 = (u.pm - __builtin_amdgcn_readfirstlane(TAB[32 + e])) * 256, cnt = __builtin_amdgcn_readfirstlane(TAB[e]);
        const int rl0 = wr * 64 + fr, col0 = u.pn * 256 + wc * 32 + 8 * fq;
        const pg8::f32x4 (&bv)[2][2] = pre.bv; float gtv[2][4];
#pragma unroll
        for (int ai = 0; ai < 2; ++ai)
#pragma unroll
            for (int m = 0; m < 4; ++m) gtv[ai][m] = (pos0 + rl0 + ai * 128 + m * 16) < cnt ? pre.gtv[ai][m] : 0.f;
#pragma unroll
        for (int ai = 0; ai < 2; ++ai)
#pragma unroll
            for (int m = 0; m < 4; ++m) { const int rl = rl0 + ai * 128 + m * 16; const float gt = gtv[ai][m], gs = gt * W8_INV;
                unsigned char* rowp = Y + (size_t)(u.pm * 256 + rl) * 1024 + col0;
#pragma unroll
                for (int bj = 0; bj < 2; ++bj) { const pg8::f32x4 v0 = acc[ai][bj][m][0] * gs + bv[bj][0] * gt, v1 = acc[ai][bj][m][1] * gs + bv[bj][1] * gt;
                    v2u w; w.x = pk4_fp8(v0[0], v0[1], v0[2], v0[3]); w.y = pk4_fp8(v1[0], v1[1], v1[2], v1[3]);
                    *(v2u*)(rowp + bj * 128) = w; } }
    }
};

__device__ const unsigned char T5_BUCKET[128] = {0, 1, 2, 3, 4, 5, 6, 7, 8, 9, 10, 11, 12, 13, 14, 15, 16, 16, 16, 17, 17, 18, 18, 18, 19, 19, 19, 20, 20, 20, 20, 21, 21, 21, 21, 22, 22, 22, 22, 22, 23, 23, 23, 23, 23, 23, 24, 24, 24, 24, 24, 24, 25, 25, 25, 25, 25, 25, 25, 26, 26, 26, 26, 26, 26, 26, 26, 27, 27, 27, 27, 27, 27, 27, 27, 27, 27, 28, 28, 28, 28, 28, 28, 28, 28, 28, 28, 29, 29, 29, 29, 29, 29, 29, 29, 29, 29, 29, 29, 30, 30, 30, 30, 30, 30, 30, 30, 30, 30, 30, 30, 30, 30, 31, 31, 31, 31, 31, 31, 31, 31, 31, 31, 31, 31, 31, 31, 31};
constexpr int KS_PITCH = 144, VT_PITCH = 520;
constexpr int ATT_KS = 0, ATT_VT = 256 * KS_PITCH, ATT_BIAS = ATT_VT + 64 * VT_PITCH;
static_assert(ATT_BIAS + 4 * 128 * 4 <= RING_BYTES, "attention LDS");
__device__ __forceinline__ int crow(int i, int hi) { return (i & 3) + 8 * (i >> 2) + 4 * hi; }
__device__ __forceinline__ void attn_unit(Frame& F, int b, int nblk, int kvh) {
    const bf16* Q = WSP(bf16, WS_Q); const bf16* KV = WSP(bf16, WS_KV); bf16* ZA = WSP(bf16, WS_ZA);
    LAS unsigned char* ks = F.lds + RING_OFF + ATT_KS; LAS unsigned char* vt = F.lds + RING_OFF + ATT_VT; LAS float* bias2 = (LAS float*)(F.lds + RING_OFF + ATT_BIAS);
    const int tid = F.tid, lane = F.lane, w = F.wave;
    const int kpos0 = (nblk - 1) * 128;
    bf16x8 qfa[2][4];
    { const int g_ = w >> 1, qh_ = kvh * 4 + g_, ql_ = lane & 31, hi_ = lane >> 5;
#pragma unroll
      for (int qt2 = 0; qt2 < 2; ++qt2) { const size_t tq_ = (size_t)b * SEQ + nblk * 128 + 32 * (2 * (w & 1) + qt2) + ql_;
#pragma unroll
          for (int s2 = 0; s2 < 4; ++s2) qfa[qt2][s2] = *(const GAS bf16x8*)(Q + tq_ * 512 + qh_ * 64 + s2 * 16 + hi_ * 8); } }
    __syncthreads();
#pragma unroll
    for (int i = 0; i < 4; ++i) {
        const int c = tid + 512 * i, row = c >> 3, part = c & 7; const int kp = kpos0 + row;
        v4u kk = (v4u){0u, 0u, 0u, 0u}, vv = (v4u){0u, 0u, 0u, 0u};
        if (kp >= 0) { const bf16* src = KV + (size_t)(b * SEQ + kp) * 256 + kvh * 64 + part * 8; kk = *(const GAS v4u*)src; vv = *(const GAS v4u*)(src + 128); }
        *(LAS v4u*)(ks + row * KS_PITCH + part * 16) = kk;
        LAS unsigned short* vd = (LAS unsigned short*)(vt + (part * 8) * VT_PITCH + row * 2);
#pragma unroll
        for (int j = 0; j < 4; ++j) { vd[(2 * j) * (VT_PITCH / 2)] = (unsigned short)(vv[j] & 0xffffu); vd[(2 * j + 1) * (VT_PITCH / 2)] = (unsigned short)(vv[j] >> 16); }
    }
    { const int g = tid >> 7, d = tid & 127; bias2[tid] = F.rel_bias[(int)T5_BUCKET[d] * 8 + kvh * 4 + g] * LOG2E; }
    __syncthreads();
    const int g = w >> 1, qh = kvh * 4 + g, ql = lane & 31, hi = lane >> 5;
    const float sink2 = F.sinks[qh] * LOG2E;
#pragma unroll 1
    for (int qt2 = 0; qt2 < 2; ++qt2) {
        const int q0 = 32 * (2 * (w & 1) + qt2), qi = q0 + ql; const size_t tq = (size_t)b * SEQ + nblk * 128 + qi;
        bf16x8 qf[4];
#pragma unroll
        for (int s = 0; s < 4; ++s) qf[s] = qt2 ? qfa[1][s] : qfa[0][s];
        f32x16 sc[5];
#pragma unroll
        for (int kt = 0; kt < 5; ++kt) {
            f32x16 a;
#pragma unroll
            for (int i = 0; i < 16; ++i) a[i] = 0.f;
            const int kb = q0 + 32 * kt;
#pragma unroll
            for (int s = 0; s < 4; ++s) { const bf16x8 kf = *(const LAS bf16x8*)(ks + (kb + ql) * KS_PITCH + s * 32 + hi * 16); a = __builtin_amdgcn_mfma_f32_32x32x16_bf16(kf, qf[s], a, 0, 0, 0); }
            sc[kt] = a;
        }
        float mx = sink2;
#pragma unroll
        for (int kt = 0; kt < 5; ++kt)
#pragma unroll
            for (int i = 0; i < 16; ++i) { const int kj = q0 + 32 * kt + crow(i, hi), dist = 128 + qi - kj; const bool ok = (dist >= 0) && (dist < 128) && (kpos0 + kj >= 0);
                const float s = ok ? sc[kt][i] * LOG2E + bias2[g * 128 + (dist & 127)] : -1e30f; sc[kt][i] = s; mx = fmaxf(mx, s); }
        mx = fmaxf(mx, __shfl_xor(mx, 32));
        float l = 0.f;
#pragma unroll
        for (int kt = 0; kt < 5; ++kt)
#pragma unroll
            for (int i = 0; i < 16; ++i) { const float p = __builtin_amdgcn_exp2f(sc[kt][i] - mx); sc[kt][i] = p; l += p; }
        l += __shfl_xor(l, 32); l += __builtin_amdgcn_exp2f(sink2 - mx);
        const float inv = 1.f / l;
        f32x16 o[2];
#pragma unroll
        for (int dt = 0; dt < 2; ++dt)
#pragma unroll
            for (int i = 0; i < 16; ++i) o[dt][i] = 0.f;
#pragma unroll
        for (int kt = 0; kt < 5; ++kt)
#pragma unroll
            for (int ss = 0; ss < 2; ++ss) {
                v4u pw;
#pragma unroll
                for (int j = 0; j < 4; ++j) pw[j] = cvt_pk_bf16(sc[kt][8 * ss + 2 * j], sc[kt][8 * ss + 2 * j + 1]);
                const bf16x8 pf = __builtin_bit_cast(bf16x8, pw);
                const int kv0 = q0 + 32 * kt + 16 * ss + 4 * hi;
#pragma unroll
                for (int dt = 0; dt < 2; ++dt) { const LAS unsigned char* vp = vt + (dt * 32 + ql) * VT_PITCH + kv0 * 2;
                    const v2u v0 = *(const LAS v2u*)vp, v1 = *(const LAS v2u*)(vp + 16); const v4u vw = (v4u){v0.x, v0.y, v1.x, v1.y};
                    o[dt] = __builtin_amdgcn_mfma_f32_32x32x16_bf16(__builtin_bit_cast(bf16x8, vw), pf, o[dt], 0, 0, 0); }
            }
        bf16* orow = ZA + tq * 1024 + 512 + qh * 64;
#pragma unroll
        for (int dt = 0; dt < 2; ++dt)
#pragma unroll
            for (int q4 = 0; q4 < 4; ++q4) { v2u ww; ww.x = cvt_pk_bf16(o[dt][4 * q4] * inv, o[dt][4 * q4 + 1] * inv); ww.y = cvt_pk_bf16(o[dt][4 * q4 + 2] * inv, o[dt][4 * q4 + 3] * inv);
                *(GAS v2u*)(orow + dt * 32 + 8 * q4 + 4 * hi) = ww; }
    }
}
__device__ __forceinline__ void p2_attn_pool(Frame& F) {
    for (int uidx = F.vcu; uidx < NB * 32 * 2; uidx += F.G) { const int kvh = uidx & 1, nblk = (uidx >> 1) & 31, b = uidx >> 6; attn_unit(F, b, nblk, kvh); }
    const bf16* U = WSP(bf16, WS_U); bf16* ZA = WSP(bf16, WS_ZA);
    for (int it = F.vcu * NWAVES + F.wave; it < T_TOK / 8; it += F.G * NWAVES) {
        const int t0 = it * 8, c8 = F.lane, g = c8 >> 4, wnd = 2 << g, pos0 = t0 & (SEQ - 1);
        const bf16* up = U + (size_t)t0 * 512 + c8 * 8;
        v4u ur[23];
#pragma unroll
        for (int j = 0; j < 23; ++j) { const int rel = j - 15; ur[j] = (v4u){0u, 0u, 0u, 0u}; if (rel > -wnd && pos0 + rel >= 0) ur[j] = *(const GAS v4u*)(up + (ptrdiff_t)rel * 512); }
#pragma unroll
        for (int i = 0; i < 8; ++i) {
            const int pos = pos0 + i, cnt = (pos + 1) < wnd ? (pos + 1) : wnd;
            float sacc[8];
#pragma unroll
            for (int q = 0; q < 4; ++q) { sacc[2 * q] = bf_lo(ur[15 + i][q]); sacc[2 * q + 1] = bf_hi(ur[15 + i][q]); }
#pragma unroll
            for (int j = 1; j < 16; ++j) { const bool on = j < cnt;
#pragma unroll
                for (int q = 0; q < 4; ++q) { const unsigned wv = ur[15 + i - j][q]; sacc[2 * q] += on ? bf_lo(wv) : 0.f; sacc[2 * q + 1] += on ? bf_hi(wv) : 0.f; } }
            const float ic = 1.0f / (float)cnt; v4u o;
#pragma unroll
            for (int q = 0; q < 4; ++q) o[q] = cvtpk_s(sacc[2 * q] * ic - bf_lo(ur[15 + i][q]), sacc[2 * q + 1] * ic - bf_hi(ur[15 + i][q]));
            *(GAS v4u*)(ZA + (size_t)(t0 + i) * 1024 + c8 * 8) = o;
        }
    }
}

constexpr int P5_OFF = 133120;
static_assert(P5_OFF >= TAB_OFF + (32 + 40 + NRT_MAX) * 4 && P5_OFF + 4 * 2304 + 256 <= LDS_BYTES, "router scratch");
__device__ __forceinline__ void p5_router(Frame& F) {
    const bf16* X1 = WSP(bf16, WS_X1); unsigned char* H2 = WSP(unsigned char, WS_H2); const char* Wg = (const char*)WSP(bf16, WS_WRT);
    int* ltok = WSP(int, WS_LTOK); float* lgate = WSP(float, WS_LGATE); float* lrstd = WSP(float, WS_LRSTD); int* toke = WSP(int, WS_TOKE); int* tokp = WSP(int, WS_TOKP);
    int lane = F.lane; asm volatile("" : "+v"(lane));
    const int w = F.wave, r = lane & 15, q = lane >> 4, rg = w;
    LAS float* lg = (LAS float*)(F.lds + P5_OFF + (rg & 3) * 2304);
    LAS int* lcnt = (LAS int*)(F.lds + P5_OFF + 4 * 2304); LAS int* lbase = lcnt + 32;
    const LAS unsigned char* wl = F.lds + RING_OFF;
    const unsigned lds0 = (unsigned)(uintptr_t)(F.lds + RING_OFF);
    for (int tb = F.vcu; tb < T_TOK / 64; tb += F.G) {
        __syncthreads();
        if (F.tid < 32) lcnt[F.tid] = 0;
        int pe[4] = {0, 0, 0, 0}, pl[4] = {0, 0, 0, 0}; float pw[4] = {0.f, 0.f, 0.f, 0.f}; float rstd = 0.f;
        const int row0 = tb * 64 + (rg & 3) * 16;
        bf16x8 xr[32];
        if (w < 4) { const bf16* xp = X1 + (size_t)(row0 + r) * 1024 + 8 * q;
#pragma unroll
            for (int s2 = 0; s2 < 32; ++s2) xr[s2] = *(const GAS bf16x8*)(xp + 32 * s2); }
#pragma unroll
        for (int j = 0; j < 16; ++j) { const int p = w * 16 + j, R = p >> 1, cd = (p & 1) * 64 + lane;
            pg8::glds16s(Wg, (unsigned)(R * 2048 + ((cd ^ ((R & 3) << 2)) << 4)), lds0 + (unsigned)p * 1024u); }
        asm volatile("s_waitcnt vmcnt(0)" ::: "memory");
        __syncthreads();
        if (w < 4) {
            pg8::f32x4 a0 = (pg8::f32x4){0.f, 0.f, 0.f, 0.f}, a1 = a0; float ss = 0.f;
            unsigned char* hp = H2 + (size_t)(row0 + r) * 1024 + 8 * q;
            const LAS unsigned char* wb = wl + r * 2048; const int sw = (r & 3) << 2;
#pragma unroll
            for (int s2 = 0; s2 < 32; ++s2) {
                const v4u xw = __builtin_bit_cast(v4u, xr[s2]);
                const pg8::f32x4 xa = (pg8::f32x4){bf_lo(xw[0]), bf_hi(xw[0]), bf_lo(xw[1]), bf_hi(xw[1])}, xb = (pg8::f32x4){bf_lo(xw[2]), bf_hi(xw[2]), bf_lo(xw[3]), bf_hi(xw[3])};
                ss += (xa[0] * xa[0] + xa[1] * xa[1]) + (xa[2] * xa[2] + xa[3] * xa[3]) + (xb[0] * xb[0] + xb[1] * xb[1]) + (xb[2] * xb[2] + xb[3] * xb[3]);
                { v2u h8; h8.x = pk4_fp8(xa[0], xa[1], xa[2], xa[3]); h8.y = pk4_fp8(xb[0], xb[1], xb[2], xb[3]); *(GAS v2u*)(hp + 32 * s2) = h8; }
                const int co = ((4 * s2 + q) ^ sw) << 4;
                const bf16x8 bh0 = *(const LAS bf16x8*)(wb + co), bh1 = *(const LAS bf16x8*)(wb + 16 * 2048 + co), bl0 = *(const LAS bf16x8*)(wb + 32 * 2048 + co), bl1 = *(const LAS bf16x8*)(wb + 48 * 2048 + co);
                a0 = __builtin_amdgcn_mfma_f32_16x16x32_bf16(xr[s2], bh0, a0, 0, 0, 0); a1 = __builtin_amdgcn_mfma_f32_16x16x32_bf16(xr[s2], bh1, a1, 0, 0, 0);
                a0 = __builtin_amdgcn_mfma_f32_16x16x32_bf16(xr[s2], bl0, a0, 0, 0, 0); a1 = __builtin_amdgcn_mfma_f32_16x16x32_bf16(xr[s2], bl1, a1, 0, 0, 0);
            }
            ss += __shfl_xor(ss, 16); ss += __shfl_xor(ss, 32);
            rstd = 1.f / sqrtf(ss * (1.f / DM) + RMS_EPS);
            const float b0 = F.b_router[r], b1 = F.b_router[16 + r];
#pragma unroll
            for (int i = 0; i < 4; ++i) { const float rs = __shfl(rstd, 4 * q + i); lg[(4 * q + i) * 36 + r] = a0[i] * rs + b0; lg[(4 * q + i) * 36 + 16 + r] = a1[i] * rs + b1; }
            LDS_WAIT(); asm volatile("" ::: "memory");
            if (lane < 16) {
                float v[32];
#pragma unroll
                for (int j = 0; j < 8; ++j) { const pg8::f32x4 t4 = *(const LAS pg8::f32x4*)(lg + lane * 36 + 4 * j); v[4 * j] = t4[0]; v[4 * j + 1] = t4[1]; v[4 * j + 2] = t4[2]; v[4 * j + 3] = t4[3]; }
                unsigned taken = 0u; float tv[4];
#pragma unroll
                for (int k = 0; k < 4; ++k) { float best = -3.0e38f; int bi = 0;
#pragma unroll
                    for (int e = 0; e < 32; ++e) { const bool c = !((taken >> e) & 1u) && (v[e] > best); best = c ? v[e] : best; bi = c ? e : bi; }
                    taken |= 1u << bi; pe[k] = bi; tv[k] = best; }
                const float e1 = __expf(tv[1] - tv[0]), e2 = __expf(tv[2] - tv[0]), e3 = __expf(tv[3] - tv[0]); const float inv = 1.f / (1.f + e1 + e2 + e3);
                pw[0] = inv; pw[1] = e1 * inv; pw[2] = e2 * inv; pw[3] = e3 * inv;
#pragma unroll
                for (int k = 0; k < 4; ++k) pl[k] = __hip_atomic_fetch_add(lcnt + pe[k], 1, __ATOMIC_RELAXED, __HIP_MEMORY_SCOPE_WORKGROUP);
            }
        }
        __syncthreads();
        if (F.tid < 32) lbase[F.tid] = (int)__hip_atomic_fetch_add(F.ctl + CW_CNT + 64 * F.tid, (unsigned)lcnt[F.tid], RLX_AGENT);
        __syncthreads();
        if (w < 4 && lane < 16) { const int tok = row0 + lane;
#pragma unroll
            for (int k = 0; k < 4; ++k) { const int e = pe[k], pos = lbase[e] + pl[k]; ltok[e * CAP + pos] = tok; lgate[e * CAP + pos] = pw[k]; lrstd[e * CAP + pos] = rstd; toke[tok * 4 + k] = e; tokp[tok * 4 + k] = pos; } }
    }
}
__device__ __forceinline__ void build_tables(Frame& F) {
    __syncthreads();
    if (F.tid < 32) F.TAB[F.tid] = (int)__hip_atomic_load(F.ctl + CW_CNT + 64 * F.tid, RLX_AGENT);
    __syncthreads();
    if (F.tid <= 32) { int acc = 0; for (int e = 0; e < F.tid; ++e) acc += (F.TAB[e] + 255) >> 8; F.TAB[32 + F.tid] = acc; }
    __syncthreads();
    if (F.tid < NRT_MAX && F.tid < F.TAB[64]) { int e = 0;
#pragma unroll 1
        for (int j = 1; j < 32; ++j) e = (F.TAB[32 + j] <= F.tid) ? j : e;
        while (e > 0 && F.TAB[32 + e] == F.TAB[32 + e + 1]) --e;
        F.TAB[72 + F.tid] = e; }
    __syncthreads();
}

__device__ __forceinline__ void p8_final(Frame& F) {
    const bf16* X1 = WSP(bf16, WS_X1); const unsigned char* Y = WSP(unsigned char, WS_Y); const int* toke = WSP(int, WS_TOKE); const int* tokp = WSP(int, WS_TOKP);
    int lane = F.lane; asm volatile("" : "+v"(lane));
    const int gw = F.vcu * NWAVES + F.wave, NGW = F.G * NWAVES;
    const GAS f32x4* gp = (const GAS f32x4*)F.final_g + lane; f32x4 g[4];
#pragma unroll
    for (int j = 0; j < 4; ++j) g[j] = gp[64 * j];
    for (int m = gw; m < T_TOK; m += NGW) {
        const GAS v2u* xr = (const GAS v2u*)(X1 + (size_t)m * DM) + lane; f32x4 v[4];
#pragma unroll
        for (int j = 0; j < 4; ++j) { const v2u xw = xr[64 * j]; v[j] = (f32x4){bf_lo(xw.x), bf_hi(xw.x), bf_lo(xw.y), bf_hi(xw.y)}; }
#pragma unroll
        for (int k = 0; k < 4; ++k) { const int e = toke[m * 4 + k], pos = tokp[m * 4 + k]; const size_t slot = (size_t)F.TAB[32 + e] * 256 + pos;
            const GAS unsigned* yr = (const GAS unsigned*)(Y + slot * 1024) + lane;
#pragma unroll
            for (int j = 0; j < 4; ++j) { const unsigned yv = yr[64 * j]; const f32x2_t lo = __builtin_amdgcn_cvt_pk_f32_fp8((int)yv, false), hi = __builtin_amdgcn_cvt_pk_f32_fp8((int)yv, true);
                v[j].x += lo[0]; v[j].y += lo[1]; v[j].z += hi[0]; v[j].w += hi[1]; } }
        float s2 = 0.f;
#pragma unroll
        for (int j = 0; j < 4; ++j) s2 += (v[j].x * v[j].x + v[j].y * v[j].y) + (v[j].z * v[j].z + v[j].w * v[j].w);
        const float rstd = 1.f / sqrtf(wave_sum(s2) * (1.f / DM) + RMS_EPS);
        GAS f32x4* o = (GAS f32x4*)(F.out + (size_t)m * DM) + lane;
#pragma unroll
        for (int j = 0; j < 4; ++j) o[64 * j] = v[j] * rstd * g[j];
    }
}

struct Args { const float* in[18]; float* out; unsigned char* ws; int ph_lo, ph_hi; };
__global__ void __launch_bounds__(NWAVES * 64, 2) mk_fwd(Args args) {
    extern __shared__ __attribute__((aligned(16))) unsigned char lds[];
    Frame F;
    F.lds = (LAS unsigned char*)lds;
    F.MISC = (volatile LAS unsigned*)(F.lds + MISC_OFF);
    F.TAB = (LAS int*)(F.lds + TAB_OFF);
    F.tid = threadIdx.x; F.lane = F.tid & 63; F.wave = __builtin_amdgcn_readfirstlane(F.tid >> 6);
    F.G = gridDim.x; F.bx = (int)blockIdx.x; F.xloc = 0; F.vcu = (F.G % 8 == 0) ? (F.bx % 8) * (F.G / 8) + F.bx / 8 : F.bx;
    F.ws = args.ws; F.ctl = (gu32*)(args.ws + WS_CTL); F.out = args.out;
    F.x = args.in[0]; F.norm1_g = args.in[1]; F.w_in = args.in[2]; F.pool_w = args.in[3]; F.pool_scale = args.in[4]; F.w_pool_proj = args.in[5]; F.sinks = args.in[6]; F.w_attn_proj = args.in[7];
    F.w_out = args.in[8]; F.norm2_g = args.in[9]; F.w_router = args.in[10]; F.b_router = args.in[11]; F.w_up = args.in[12]; F.b_up = args.in[13]; F.w_down = args.in[14]; F.b_down = args.in[15];
    F.rel_bias = args.in[16]; F.final_g = args.in[17];
    for (int u = F.tid; u < (LDS_BYTES - LDSCTL_OFF) / 4; u += NWAVES * 64) ((LAS unsigned*)(F.lds + LDSCTL_OFF))[u] = 0u;
    __syncthreads();
    XcdBarrier bar; bar.bar = (unsigned*)(F.ctl + CW_BAR); bar.x = 0; bar.st = nullptr;
    if (N_LAUNCHES == 1) bar = xcd_barrier_post((unsigned*)(F.ctl + CW_BAR), F.MISC + 8);
#define GRID_BAR() do { if (N_LAUNCHES == 1) xcd_barrier(bar); } while (0)
    const int lo = args.ph_lo, hi = args.ph_hi;
#ifndef PHASE_MASK
#define PHASE_MASK 0x1ff
#endif
#define IN(k) ((((PHASE_MASK) >> (k)) & 1) && lo <= (k) && (k) < hi)
    using pg8::StaticOrder;
#ifndef REP_MASK
#define REP_MASK 0
#endif
#define REP(k) (((REP_MASK) >> (k)) & 1)
#define PH0() do { p0_prologue(F); } while (0)
#define PH1() do { { ProbDense P{(const char*)WSP(bf16, WS_H1), (const char*)WSP(bf16, WS_WIN)}; EpiInProj E{WSP(bf16, WS_U), WSP(bf16, WS_Q), WSP(bf16, WS_KV), WSP(bf16, WS_GP), WSP(bf16, WS_GA)}; \
            if (F.G == 256) { P1Order S{F.bx & 7, F.bx >> 3, 0}; pg8::gemm_phase<ProbDense, EpiInProj, P1Order, true>(F.lds + RING_OFF, P, S, E); } \
            else { StaticOrder S; S.init(T_TOK / 256, 5, F.G, F.bx); pg8::gemm_phase<ProbDense, EpiInProj, StaticOrder, true>(F.lds + RING_OFF, P, S, E); } } \
        { ProbDense8 P{(const char*)WSP(unsigned char, WS_H18), (const char*)WSP(unsigned char, WS_WIN8)}; EpiGate8 E{WSP(unsigned char, WS_GP), WSP(unsigned char, WS_GA)}; \
            if (F.G == 256) { P1Order S{F.bx & 7, F.bx >> 3, 1}; pg8::gemm_phase<ProbDense8, EpiGate8, P1Order, true>(F.lds + RING_OFF, P, S, E); } \
            else { StaticOrder S; S.init(T_TOK / 256, 8, F.G, F.bx); pg8::gemm_phase<ProbDense8, EpiGate8, StaticOrder, true>(F.lds + RING_OFF, P, S, E); } } } while (0)
#ifndef CV_A
#define CV_A 3
#endif
#ifndef CV_B
#define CV_B 5
#endif
#define STG_RANK (((F.bx >> 4) << 3) + (F.bx & 7))
#define STG_PRE_W(W_, base, cvb) do { if (F.G == 256 && ((F.bx >> 3) & 1)) convert_moe_w<W_>(F, (base), (base) + 128 * (cvb), STG_RANK, 128); } while (0)
#define STG_POST_W(W_, base, cva, cvb) do { if (F.G == 256) { if (!((F.bx >> 3) & 1)) convert_moe_w<W_>(F, (base) + 128 * (cvb), (base) + 128 * ((cva) + (cvb)), STG_RANK, 128); } \
        else convert_moe_w<W_>(F, (base), (base) + 128 * ((cva) + (cvb)), F.vcu, F.G); } while (0)
#define STG_PRE(base, cvb) STG_PRE_W(1, base, cvb)
#define STG_POST(base, cva, cvb) STG_POST_W(1, base, cva, cvb)
#ifndef CV2_A
#define CV2_A 0
#endif
#ifndef CV2_B
#define CV2_B 0
#endif
#define CV_P2BASE (2 * 128 * (CV_A + CV_B))
#define CV_P5BASE (CV_P2BASE + 128 * (CV2_A + CV2_B))
#define PH2() do { if (F.xloc) STG_PRE_W(0, 0, 2); p2_attn_pool(F); if (F.xloc) STG_POST_W(0, 0, 1, 2); } while (0)
#define PH3() do { STG_PRE(0, CV_B); { ProbDense P{(const char*)WSP(bf16, WS_ZA), (const char*)WSP(bf16, WS_WMIX)}; StaticOrder S; S.init(T_TOK / 256, DM / 256, F.G, F.bx); \
        EpiMix E{WSP(unsigned char, WS_GP), WSP(unsigned char, WS_GA), WSP(bf16, WS_MIX)}; \
        pg8::gemm_phase<ProbDense, EpiMix, StaticOrder, true>(F.lds + RING_OFF, P, S, E); } STG_POST(0, CV_A, CV_B); } while (0)
#define PH4() do { STG_PRE(128 * (CV_A + CV_B), CV_B); { ProbDense P{(const char*)WSP(bf16, WS_MIX), (const char*)WSP(bf16, WS_WOUT)}; StaticOrder S; S.init(T_TOK / 256, DM / 256, F.G, F.bx); \
        EpiOut E{F.x, WSP(bf16, WS_X1)}; \
        pg8::gemm_phase<ProbDense, EpiOut, StaticOrder, true>(F.lds + RING_OFF, P, S, E); } STG_POST(128 * (CV_A + CV_B), CV_A, CV_B); } while (0)
#ifndef CV5_A
#define CV5_A 2
#endif
#ifndef CV5_B
#define CV5_B 3
#endif
#define DN_P1BASE (DN_SPLIT + 128 * (CV5_A + CV5_B))
#define PH5() do { STG_PRE_W(0, DN_SPLIT, CV5_B); p5_router(F); convert_moe_w<1>(F, CV_P5BASE, NEXP * 64, F.vcu, F.G); STG_POST_W(0, DN_SPLIT, CV5_A, CV5_B); } while (0)
#define PH6() do { ProbUp P{(const char*)WSP(bf16, WS_H2), (const char*)WSP(bf16, WS_WUP), WSP(int, WS_LTOK), F.TAB}; EpiUp E{F.b_up, WSP(float, WS_LRSTD), WSP(unsigned char, WS_ACT), F.TAB}; \
        const int nrt = __builtin_amdgcn_readfirstlane(F.TAB[64]); \
        if (F.xloc) { pg8::XccProducer S; S.init(nrt, 8, F.bx & 7, F.bx >> 3, 0); S.cnt = (unsigned*)(F.ctl + CW_RTC); pg8::gemm_phase<ProbUp, EpiUp, pg8::XccProducer, true>(F.lds + RING_OFF, P, S, E); } \
        else { StaticOrder S; S.init(nrt, 8, F.G, F.bx); pg8::gemm_phase<ProbUp, EpiUp, StaticOrder, true>(F.lds + RING_OFF, P, S, E); \
            { const int nwg = S.nwg, R = (nwg + F.G - 1) / F.G, nidle = R * F.G - nwg, c = F.bx; \
              if (nidle == 0) convert_moe_w<0>(F, 0, DN_SPLIT, c, F.G); else if (c >= F.G - nidle) convert_moe_w<0>(F, 0, DN_SPLIT, c - (F.G - nidle), nidle); } } } while (0)
#define PH7() do { ProbDown P{(const char*)WSP(bf16, WS_ACT), (const char*)WSP(bf16, WS_WDN), F.TAB}; EpiDown E{F.b_down, WSP(float, WS_LGATE), WSP(unsigned char, WS_Y), F.TAB}; \
        const int nrt = __builtin_amdgcn_readfirstlane(F.TAB[64]); \
        if (F.xloc) { pg8::XccConsumer S; { pg8::XccOrder U; U.init(nrt, 8, F.bx & 7, F.bx >> 3, 0); S.init(nrt, 4, F.bx & 7, F.bx >> 3, U.n); } S.cnt = (unsigned*)(F.ctl + CW_RTC); S.tmo = (unsigned*)(F.ctl + CW_TMO); \
            pg8::gemm_phase<ProbDown, EpiDown, pg8::XccConsumer, true>(F.lds + RING_OFF, P, S, E); } \
        else { StaticOrder S; S.init(nrt, 4, F.G, F.bx); pg8::gemm_phase<ProbDown, EpiDown, StaticOrder, true>(F.lds + RING_OFF, P, S, E); } } while (0)
#define PH8() do { p8_final(F); } while (0)
    if (IN(0)) { PH0(); GRID_BAR(); if (REP(0)) { PH0(); GRID_BAR(); } }
    if (N_LAUNCHES == 1 && lo == 0) {
        if (F.tid == 0) { int rank = 0, dense = 0; const int ok = xcc_layout(bar, rank, dense); F.MISC[12] = (unsigned)ok; F.MISC[13] = (unsigned)(rank * 8 + dense); }
        __syncthreads();
        if (F.MISC[12]) { F.xloc = 1; F.bx = (int)F.MISC[13]; F.vcu = (F.bx % 8) * (F.G / 8) + F.bx / 8; }
    }
#define LOCAL_BAR() do { if (N_LAUNCHES == 1) { if (F.xloc) xcc_barrier(bar); else xcd_barrier(bar); } } while (0)
    if (IN(1)) { PH1(); GRID_BAR(); if (REP(1)) { PH1(); GRID_BAR(); } }
    if (IN(2)) { PH2(); LOCAL_BAR(); if (REP(2)) { PH2(); LOCAL_BAR(); } }
    if (IN(3)) { PH3(); LOCAL_BAR(); if (REP(3)) { PH3(); LOCAL_BAR(); } }
    if (IN(4)) { PH4(); LOCAL_BAR(); if (REP(4)) { PH4(); LOCAL_BAR(); } }
    if (IN(5)) { PH5(); GRID_BAR(); if (REP(5)) { if (blockIdx.x == 0 && F.tid < 32) __hip_atomic_store(F.ctl + CW_CNT + 64 * F.tid, 0u, RLX_AGENT); GRID_BAR(); PH5(); GRID_BAR(); } }
    if (IN(6) || IN(7) || IN(8)) build_tables(F);
    if (IN(6)) { PH6(); if (!F.xloc) GRID_BAR(); if (REP(6)) { PH6(); GRID_BAR(); } }
    if (IN(7)) { PH7(); GRID_BAR(); if (REP(7)) { PH7(); GRID_BAR(); } }
    if (IN(8)) { PH8(); if (REP(8)) { GRID_BAR(); PH8(); } }
#undef IN
}

extern "C" void kernel_launch(void* const* d_in, const int* in_sizes, int n_in, void* d_out, int out_size, void* d_ws, size_t ws_size, hipStream_t stream) {
    static int grid = 0;
    if (grid == 0) {
        if (n_in != 18 || out_size != T_TOK * DM || ws_size < WS_END) { fprintf(stderr, "kernel_launch: unexpected problem (n_in %d out %d ws %zu)\n", n_in, out_size, ws_size); grid = -1; return; }
        int dev = 0, cus = 0, per_cu = 0;
        if (hipGetDevice(&dev) != hipSuccess || hipDeviceGetAttribute(&cus, hipDeviceAttributeMultiprocessorCount, dev) != hipSuccess) { grid = -1; return; }
        if (hipFuncSetAttribute((const void*)mk_fwd, hipFuncAttributeMaxDynamicSharedMemorySize, LDS_BYTES) != hipSuccess) { fprintf(stderr, "kernel_launch: hipFuncSetAttribute failed\n"); grid = -1; return; }
        if (hipOccupancyMaxActiveBlocksPerMultiprocessor(&per_cu, (const void*)mk_fwd, NWAVES * 64, LDS_BYTES) != hipSuccess || per_cu < 1) fprintf(stderr, "kernel_launch: occupancy query says %d\n", per_cu);
        (void)hipGetLastError();
        grid = cus;
    }
    if (grid < 0) return;
    if (hipMemsetAsync((char*)d_ws + WS_CTL, 0, CTL_ZERO_BYTES, stream) != hipSuccess) return;
    Args a{};
    for (int i = 0; i < 18; ++i) a.in[i] = (const float*)d_in[i];
    a.out = (float*)d_out; a.ws = (unsigned char*)d_ws;
    if (N_LAUNCHES == 1) { a.ph_lo = 0; a.ph_hi = PER_PHASE; hipLaunchKernelGGL(mk_fwd, dim3(grid), dim3(NWAVES * 64), LDS_BYTES, stream, a); }
    else { for (int p = 0; p < PER_PHASE; ++p) { a.ph_lo = p; a.ph_hi = p + 1; hipLaunchKernelGGL(mk_fwd, dim3(grid), dim3(NWAVES * 64), LDS_BYTES, stream, a); } }
}
```

```cpp
#include <hip/hip_runtime.h>
#include <cstdio>
#include <cstdint>

#ifndef MK_N_LAUNCHES
#define MK_N_LAUNCHES 1
#endif

constexpr int T_TOK = 16384, DM = 1024, SEQ = 4096, NB = 4;
constexpr int INW = 3328;
constexpr int NEXP = 32, TOPK = 4, DFF = 1024;
constexpr int CAP = 16384;
constexpr int NRT_MAX = 288;
constexpr int SLOT_ROWS = NRT_MAX * 256;
constexpr float RMS_EPS = 1e-5f;
constexpr float LOG2E = 1.4426950408889634f;

namespace pg8 {
#define PG8_LAS __attribute__((address_space(3)))
typedef unsigned short bf16_t;
typedef short bf16x8 __attribute__((ext_vector_type(8)));
typedef float f32x4 __attribute__((ext_vector_type(4)));
typedef float f32x2 __attribute__((ext_vector_type(2)));
typedef unsigned u32x4 __attribute__((ext_vector_type(4)));
typedef unsigned u32x2 __attribute__((ext_vector_type(2)));
constexpr int BM = 256, BK = 64, HALF = 128, HTB = HALF * BK * 2, STAGE_BYTES = 8 * HTB, NXCD = 8, WGM = 8;
constexpr int GK = 1024;

__host__ __device__ __forceinline__ int lds_byte(int r, int c) { const int st = (r >> 4) * 2 + (c >> 5), rr = r & 15, cc = c & 31, ob = rr * 64 + cc * 2; return st * 1024 + (ob ^ (((ob >> 9) & 1) << 5)); }
__host__ __device__ __forceinline__ void stage_rc(int b, int& R, int& C) { const int st = b / 1024, sb = b % 1024, swz = sb ^ (((sb >> 9) & 1) << 5); R = (st >> 1) * 16 + swz / 64; C = (st & 1) * 32 + (swz % 64) / 2; }
__host__ __device__ __forceinline__ int perm32(int rho) { const int n = rho >> 4, i = rho & 15; return 8 * (i >> 2) + 4 * n + (i & 3); }

struct Unit { int pm, pn; };
typedef int v4i_t __attribute__((ext_vector_type(4)));
typedef int v8i_t __attribute__((ext_vector_type(8)));
__device__ __forceinline__ v8i_t cat8(bf16x8 lo, bf16x8 hi) { return __builtin_shufflevector(__builtin_bit_cast(v4i_t, lo), __builtin_bit_cast(v4i_t, hi), 0, 1, 2, 3, 4, 5, 6, 7); }

struct StaticOrder {
    static constexpr bool WAITS = false, PUBLISHES = false;
    int nM, nN, nwg, G, c;
    __host__ __device__ void init(int nM_, int nN_, int G_, int c_) { nM = nM_; nN = nN_; nwg = nM * nN; G = G_; c = c_; }
    __host__ __device__ bool next(int i, Unit& u) const {
        const long L = (long)i * G + c; if (L >= nwg) return false;
        int wgid = (int)L; { const int q = nwg / NXCD, r = nwg % NXCD, xcd = wgid % NXCD, off = wgid / NXCD; wgid = (xcd < r ? xcd * (q + 1) : r * (q + 1) + (xcd - r) * q) + off; }
        const int nig = WGM * nN, gid = wgid / nig, fm = gid * WGM, gsz = (nM - fm) < WGM ? (nM - fm) : WGM;
        u.pm = fm + ((wgid % nig) % gsz); u.pn = (wgid % nig) / gsz; return true;
    }
};

__device__ __forceinline__ void glds16s(const char* sbase, unsigned voff, unsigned lds_dst) { unsigned keep;
    asm volatile("s_mov_b32 %0, m0\n\ts_mov_b32 m0, %3\n\ts_nop 2\n\tglobal_load_lds_dwordx4 %1, %2\n\ts_mov_b32 m0, %0" : "=&s"(keep) : "v"(voff), "s"(sbase), "s"(lds_dst) : "memory"); }
struct XccOrder {
    static constexpr bool WAITS = false, PUBLISHES = false;
    int r0, nr, nN, n, skip, r;
    __host__ __device__ void init(int nM, int nN_, int x, int r_, int skip_) { r0 = x * nM / NXCD; nr = (x + 1) * nM / NXCD - r0; nN = nN_; n = nr * nN; skip = skip_; r = r_; }
    __host__ __device__ int first_i() const { return skip <= r ? 0 : (skip - r + 31) / 32; }
    __host__ __device__ bool next(int i, Unit& u) const {
        const int k = (i + first_i()) * 32 + r - skip; if (k < 0 || k >= n) return false;
        constexpr int WG = 4; const int nig = WG * nN, gid = k / nig, fm = gid * WG, gsz = (nr - fm) < WG ? (nr - fm) : WG;
        u.pm = r0 + fm + ((k % nig) % gsz); u.pn = (k % nig) / gsz; return true;
    }
};
struct XccProducer : XccOrder {
    static constexpr bool WAITS = false, PUBLISHES = true;
    unsigned* cnt;
    __device__ __forceinline__ void publish(const Unit& u) const {
        if ((threadIdx.x & 63) == 0) __hip_atomic_fetch_add(cnt + 64 * u.pm, 1u, __ATOMIC_RELAXED, __HIP_MEMORY_SCOPE_AGENT); }
};
struct XccConsumer : XccOrder {
    static constexpr bool WAITS = true, PUBLISHES = false;
    unsigned* cnt; unsigned* tmo;
    __device__ __forceinline__ void a_ready(const Unit& u) const {
        if (threadIdx.x < 64) {
            unsigned sp = 0u;
            while ((unsigned)__builtin_amdgcn_readfirstlane(__hip_atomic_load(cnt + 64 * u.pm, __ATOMIC_RELAXED, __HIP_MEMORY_SCOPE_AGENT)) < 64u) {
                __builtin_amdgcn_s_sleep(2);
                if ((++sp & 255u) == 0u) { if (__builtin_amdgcn_readfirstlane(__hip_atomic_load(tmo, __ATOMIC_RELAXED, __HIP_MEMORY_SCOPE_AGENT)) != 0u) break;
                    if (sp > (1u << 20)) { if (threadIdx.x == 0) __hip_atomic_store(tmo, 1u, __ATOMIC_RELAXED, __HIP_MEMORY_SCOPE_AGENT); break; } } }
            __builtin_amdgcn_fence(__ATOMIC_ACQUIRE, "agent");
            asm volatile("s_waitcnt vmcnt(0)" ::: "memory");
        }
        asm volatile("" ::: "memory"); __builtin_amdgcn_s_barrier(); asm volatile("" ::: "memory");
    }
};
__device__ __forceinline__ unsigned cvt_pk_bf16(float lo, float hi) { unsigned r; asm volatile("v_cvt_pk_bf16_f32 %0, %1, %2" : "=v"(r) : "v"(lo), "v"(hi)); return r; }
__device__ __forceinline__ float bf_lo(unsigned w) { return __uint_as_float(w << 16); }
__device__ __forceinline__ float bf_hi(unsigned w) { return __uint_as_float(w & 0xffff0000u); }

template <class Prob, class Epi, class Sched, bool ALIGN_EPI>
__device__ __forceinline__ void gemm_phase(PG8_LAS unsigned char* lds, const Prob& P, const Sched& S, const Epi& E) {
    const int tid = threadIdx.x, wid = __builtin_amdgcn_readfirstlane(tid >> 6), lane = tid & 63, wr = wid >> 2, wc = wid & 3, fr = lane & 15, fq = lane >> 4;
    constexpr bool FP8 = Prob::FP8;
    constexpr int RB = FP8 ? GK : GK * 2;
    constexpr int nt = FP8 ? GK / 128 : GK / BK;
    unsigned voffA[2], voffB[2];
#pragma unroll
    for (int i = 0; i < 2; ++i) { int R, C; stage_rc(tid * 16 + i * 8192, R, C); const int Rb = Epi::PERM ? ((R & ~31) + perm32(R & 31)) : R;
        voffA[i] = (unsigned)(R * RB + C * 2); voffB[i] = (unsigned)(Rb * RB + C * 2); }
#define PG8_GATHER_LOAD(u, G_) do { int tid_ = tid; asm volatile("" : "+v"(tid_)); _Pragma("unroll") for (int i = 0; i < 2; ++i) { int R, C; stage_rc(tid_ * 16 + i * 8192, R, C); \
        G_[i] = P.a_rowoff(u, R); G_[2 + i] = P.a_rowoff(u, HALF + R); } } while (0)
#define PG8_GATHER_OFFS(G_, D0, D1) do { int tid_ = tid; asm volatile("" : "+v"(tid_)); _Pragma("unroll") for (int i = 0; i < 2; ++i) { int R, C; stage_rc(tid_ * 16 + i * 8192, R, C); \
        D0[i] = G_[i] * (unsigned)RB + (unsigned)(C * 2); D1[i] = G_[2 + i] * (unsigned)RB + (unsigned)(C * 2); } } while (0)
    constexpr size_t kstep = (size_t)(BK * 2);
    constexpr size_t hstep = (size_t)HALF * RB;
    const unsigned ldsw = (unsigned)wid * 1024u, lds0 = (unsigned)(uintptr_t)lds;
    const int aoff = lds_byte(wr * 64 + fr, fq * 8), boff = lds_byte(wc * 32 + fr, fq * 8);
#define PG8_SA(b, h) (((b) * 2 + (h)) * HTB)
#define PG8_SB(b, h) ((4 + (b) * 2 + (h)) * HTB)
#define PG8_STAGE(bufoff, gbase, voff) do { _Pragma("unroll") for (int _i = 0; _i < 2; ++_i) glds16s((const char*)(gbase), (voff)[_i], lds0 + (unsigned)(bufoff) + ldsw + (unsigned)(_i * 8192)); } while (0)
#define PG8_STAGE_A(b, h, gbase, VOG) do { if constexpr (Prob::GATHER) { PG8_STAGE(PG8_SA(b, h), (gbase), VOG); } else { PG8_STAGE(PG8_SA(b, h), (gbase) + (h) * hstep, voffA); } } while (0)
#define PG8_LDA(dst, b, h) do { _Pragma("unroll") for (int m = 0; m < 4; ++m) { if constexpr (FP8) { dst##8[m] = cat8(*(const PG8_LAS bf16x8*)(lds + PG8_SA(b, h) + aoff + m * 2048), *(const PG8_LAS bf16x8*)(lds + PG8_SA(b, h) + aoff + m * 2048 + 1024)); } \
        else { _Pragma("unroll") for (int k = 0; k < 2; ++k) dst[m][k] = *(const PG8_LAS bf16x8*)(lds + PG8_SA(b, h) + aoff + m * 2048 + k * 1024); } } } while (0)
#define PG8_LDB(dst, b, h) do { _Pragma("unroll") for (int n = 0; n < 2; ++n) { if constexpr (FP8) { dst##8[n] = cat8(*(const PG8_LAS bf16x8*)(lds + PG8_SB(b, h) + boff + n * 2048), *(const PG8_LAS bf16x8*)(lds + PG8_SB(b, h) + boff + n * 2048 + 1024)); } \
        else { _Pragma("unroll") for (int k = 0; k < 2; ++k) dst[n][k] = *(const PG8_LAS bf16x8*)(lds + PG8_SB(b, h) + boff + n * 2048 + k * 1024); } } } while (0)
#define PG8_MMA(ai, bj, At, Bt) do { __builtin_amdgcn_s_setprio(1); _Pragma("unroll") for (int m = 0; m < 4; ++m) _Pragma("unroll") for (int n = 0; n < 2; ++n) { \
        if constexpr (FP8) { asm volatile("v_mfma_f32_16x16x128_f8f6f4 %0, %1, %2, %0" : "+v"(acc[ai][bj][m][n]) : "v"(Bt##8[n]), "v"(At##8[m])); } \
        else { _Pragma("unroll") for (int k = 0; k < 2; ++k) acc[ai][bj][m][n] = __builtin_amdgcn_mfma_f32_16x16x32_bf16(Bt[n][k], At[m][k], acc[ai][bj][m][n], 0, 0, 0); } } \
        __builtin_amdgcn_s_setprio(0); } while (0)
#define PG8_WAIT_V(n) asm volatile("s_waitcnt vmcnt(" #n ")" ::: "memory")
#define PG8_WAIT_L(n) asm volatile("s_waitcnt lgkmcnt(" #n ")" ::: "memory")
#define PG8_BAR __builtin_amdgcn_s_barrier()
#define PG8_SCHED __builtin_amdgcn_sched_barrier(0)
    Unit cur, nxt; int ui = 0;
    if (!S.next(0, cur)) return;
    f32x4 acc[2][2][4][2];
#pragma unroll
    for (int a = 0; a < 2; ++a)
#pragma unroll
        for (int b = 0; b < 2; ++b)
#pragma unroll
            for (int m = 0; m < 4; ++m)
#pragma unroll
                for (int n = 0; n < 2; ++n) acc[a][b][m][n] = (f32x4){0.f, 0.f, 0.f, 0.f};
    bf16x8 At[4][2], B0[2][2], B1[2][2]; v8i_t At8[4], B08[2], B18[2]; typename Epi::Pre pre;
    const char* cA = P.a_tile(cur); const char* cB = P.b_tile(cur); Unit prv = cur;
    if constexpr (Sched::WAITS) S.a_ready(cur);
    unsigned vA0[2] = {0u, 0u}, vA1[2] = {0u, 0u}, vL1[2] = {0u, 0u};
    unsigned gix[4] = {0u, 0u, 0u, 0u};
    if constexpr (Prob::GATHER) { PG8_GATHER_LOAD(cur, gix); PG8_GATHER_OFFS(gix, vA0, vA1); vL1[0] = vA1[0]; vL1[1] = vA1[1]; }
    PG8_STAGE(PG8_SB(0, 0), cB, voffB); PG8_STAGE(PG8_SB(0, 1), cB + hstep, voffB); PG8_STAGE_A(0, 0, cA, vA0); PG8_STAGE_A(0, 1, cA, vA1);
    if (wr == 1) PG8_BAR;
    PG8_WAIT_V(2); PG8_BAR;
    PG8_STAGE(PG8_SB(1, 0), cB + kstep, voffB); PG8_STAGE_A(1, 0, cA + kstep, vA0); PG8_STAGE(PG8_SB(1, 1), cB + hstep + kstep, voffB);
    PG8_WAIT_V(6); PG8_BAR;
    for (;;) {
        const bool has_next = S.next(ui + 1, nxt);
        const char* nA = has_next ? P.a_tile(nxt) : cA; const char* nB = has_next ? P.b_tile(nxt) : cB;
        constexpr int NSEG = (Epi::MID > 0) ? 2 : 1;
#pragma unroll
        for (int seg = 0; seg < NSEG; ++seg) {
        if constexpr (Epi::MID > 0) { if (seg == 1) E.mid(acc, cur, wr, wc, fr, fq); }
        const int t_lo = (seg == 0) ? 0 : Epi::MID, t_hi = (Epi::MID > 0 && seg == 0) ? Epi::MID : nt;
#pragma unroll 1
        for (int t = t_lo; t < t_hi; t += 2) {
            const bool last = (t == nt - 2);
            const char* a1 = cA + (size_t)(t + 1) * kstep;
            const char* a2 = last ? nA : cA + (size_t)(t + 2) * kstep; const char* b2 = last ? nB : cB + (size_t)(t + 2) * kstep;
            const char* a3 = a2 + kstep; const char* b3 = b2 + kstep;
            if constexpr (Sched::WAITS) { if (last && has_next) S.a_ready(nxt); }
            if constexpr (Prob::GATHER) { if (has_next) { if (t == nt - 4) { PG8_GATHER_LOAD(nxt, gix); } if (last) { PG8_GATHER_OFFS(gix, vA0, vA1); } } }
            if constexpr (Epi::PREFETCH) { if (last) { int fr_ = fr, fq_ = fq; asm volatile("" : "+v"(fr_), "+v"(fq_)); E.prefetch(pre, cur, wr, wc, fr_, fq_); } }
            PG8_LDB(B0, 0, 0); PG8_LDB(B1, 0, 1); PG8_SCHED; PG8_LDA(At, 0, 0); PG8_STAGE_A(1, 1, a1, vL1);
            PG8_WAIT_V(8); PG8_WAIT_L(0); PG8_BAR; PG8_MMA(0, 0, At, B0); PG8_MMA(0, 1, At, B1); PG8_BAR; PG8_SCHED;
            PG8_LDA(At, 0, 1); PG8_STAGE(PG8_SB(0, 0), b2, voffB); PG8_STAGE(PG8_SB(0, 1), b2 + hstep, voffB); PG8_STAGE_A(0, 0, a2, vA0);
            PG8_WAIT_V(8); PG8_WAIT_L(0); PG8_BAR; PG8_MMA(1, 0, At, B0); PG8_MMA(1, 1, At, B1); PG8_BAR; PG8_SCHED;
            PG8_LDB(B0, 1, 0); PG8_LDB(B1, 1, 1); PG8_SCHED; PG8_LDA(At, 1, 0); PG8_STAGE_A(0, 1, a2, vA1);
            PG8_WAIT_V(8); PG8_WAIT_L(0); PG8_BAR; PG8_MMA(0, 0, At, B0); PG8_MMA(0, 1, At, B1); PG8_BAR; PG8_SCHED;
            PG8_LDA(At, 1, 1); PG8_STAGE(PG8_SB(1, 0), b3, voffB); PG8_STAGE(PG8_SB(1, 1), b3 + hstep, voffB); PG8_STAGE_A(1, 0, a3, vA0);
            PG8_WAIT_V(8); PG8_WAIT_L(0); PG8_BAR; PG8_MMA(1, 0, At, B0); PG8_MMA(1, 1, At, B1); PG8_BAR; PG8_SCHED;
        }
        }
        if constexpr (ALIGN_EPI) { if (wr == 0) PG8_BAR; }
        if constexpr (Sched::PUBLISHES) { if (ui > 0) { PG8_WAIT_V(0); S.publish(prv); } }
        if constexpr (FP8) asm volatile("s_nop 15\n\ts_nop 15" ::: "memory");
        { int fr_ = fr, fq_ = fq; asm volatile("" : "+v"(fr_), "+v"(fq_) :: "memory");
          E(acc, pre, cur, wr, wc, fr_, fq_); }
        if (!has_next) break;
#pragma unroll
        for (int a = 0; a < 2; ++a)
#pragma unroll
            for (int b = 0; b < 2; ++b)
#pragma unroll
                for (int m = 0; m < 4; ++m)
#pragma unroll
                    for (int n = 0; n < 2; ++n) acc[a][b][m][n] = (f32x4){0.f, 0.f, 0.f, 0.f};
        prv = cur; cur = nxt; cA = nA; cB = nB; ++ui;
        if constexpr (Prob::GATHER) { vL1[0] = vA1[0]; vL1[1] = vA1[1]; }
        if constexpr (ALIGN_EPI) { if (wr == 1) PG8_BAR; }
    }
    PG8_WAIT_V(0);
    if constexpr (Sched::PUBLISHES) S.publish(cur);
    if constexpr (!ALIGN_EPI) { if (wr == 0) PG8_BAR; }
    PG8_BAR;
#undef PG8_SA
#undef PG8_SB
#undef PG8_STAGE
#undef PG8_STAGE_A
#undef PG8_GATHER_OFFS
#undef PG8_GATHER_LOAD
#undef PG8_LDA
#undef PG8_LDB
#undef PG8_MMA
#undef PG8_WAIT_V
#undef PG8_WAIT_L
#undef PG8_BAR
#undef PG8_SCHED
}
}

constexpr int NWAVES = 8;
constexpr int N_LAUNCHES = MK_N_LAUNCHES;
constexpr int PER_PHASE = 9;

constexpr size_t MiB = 1u << 20;
constexpr size_t WS_CTL = 0, CTL_ZERO_BYTES = 1 * MiB;
constexpr size_t WS_WIN = 2 * MiB;
constexpr size_t WS_WMIX = 10 * MiB;
constexpr size_t WS_WOUT = 12 * MiB;
constexpr size_t WS_WRT = 14 * MiB;
constexpr size_t WS_WUP = 16 * MiB;
constexpr size_t WS_WDN = 144 * MiB;
constexpr size_t WS_H1 = 208 * MiB;
constexpr size_t WS_U = 240 * MiB;
constexpr size_t WS_Q = 256 * MiB;
constexpr size_t WS_KV = 272 * MiB;
constexpr size_t WS_GP = 280 * MiB;
constexpr size_t WS_GA = 312 * MiB;
constexpr size_t WS_ZA = 344 * MiB;
constexpr size_t WS_MIX = 376 * MiB;
constexpr size_t WS_X1 = 408 * MiB;
constexpr size_t WS_H2 = 472 * MiB;
constexpr size_t WS_LTOK = 504 * MiB;
constexpr size_t WS_LGATE = 506 * MiB;
constexpr size_t WS_LRSTD = 508 * MiB;
constexpr size_t WS_TOKE = 510 * MiB;
constexpr size_t WS_TOKP = 511 * MiB;
constexpr size_t WS_ACT = 512 * MiB;
constexpr size_t WS_Y = 656 * MiB;
constexpr size_t WS_H18 = 800 * MiB;
constexpr size_t WS_WIN8 = 816 * MiB;
constexpr size_t WS_END = 820 * MiB;
constexpr int CW_TMO = 0, CW_CODE = 1;
constexpr int CW_CNT = 1024;
constexpr int CW_BAR = 4096;
constexpr int CW_RTC = 32768;

constexpr int RING_OFF = 0, RING_BYTES = 131072;
constexpr int LDSCTL_OFF = RING_BYTES, MISC_OFF = LDSCTL_OFF + 320;
constexpr int TAB_OFF = MISC_OFF + 128;
constexpr int LDS_BYTES = 147456;
static_assert(TAB_OFF + (32 + 40 + NRT_MAX) * 4 <= LDS_BYTES, "LDS map");

#define GAS __attribute__((address_space(1)))
#define LAS __attribute__((address_space(3)))
typedef unsigned short bf16;
typedef unsigned v4u __attribute__((ext_vector_type(4)));
typedef unsigned v2u __attribute__((ext_vector_type(2)));
typedef float f32x4 __attribute__((ext_vector_type(4)));
typedef float f32x16 __attribute__((ext_vector_type(16)));
typedef short bf16x8 __attribute__((ext_vector_type(8)));
typedef GAS unsigned gu32;
#define RLX_AGENT __ATOMIC_RELAXED, __HIP_MEMORY_SCOPE_AGENT
#define LDS_WAIT() asm volatile("s_waitcnt lgkmcnt(0)" ::: "memory")
#define VM_WAIT() asm volatile("s_waitcnt vmcnt(0)" ::: "memory")
__device__ __forceinline__ unsigned f2bf(float f) { unsigned u = __builtin_bit_cast(unsigned, f); return (u + 0x7fffu + ((u >> 16) & 1u)) >> 16; }
__device__ __forceinline__ unsigned pk2(float lo, float hi) { return f2bf(lo) | (f2bf(hi) << 16); }
using pg8::cvt_pk_bf16; using pg8::bf_lo; using pg8::bf_hi;
typedef float f32x2_t __attribute__((ext_vector_type(2)));
typedef __bf16 bf16x2_t __attribute__((ext_vector_type(2)));
__device__ __forceinline__ unsigned cvtpk_s(float lo, float hi) { f32x2_t v = {lo, hi}; bf16x2_t b = __builtin_convertvector(v, bf16x2_t); return __builtin_bit_cast(unsigned, b); }

constexpr float W8_SCALE = 256.0f, W8_INV = 1.0f / 256.0f;
__device__ __forceinline__ float sat8(float x) { return __builtin_amdgcn_fmed3f(x, -448.f, 448.f); }
__device__ __forceinline__ unsigned pk4_fp8(float a, float b, float c, float d) { int w = 0; w = __builtin_amdgcn_cvt_pk_fp8_f32(sat8(a), sat8(b), w, false); w = __builtin_amdgcn_cvt_pk_fp8_f32(sat8(c), sat8(d), w, true); return (unsigned)w; }
#define XB_TMO      128
#define XB_XCNT(j)  (256  + 64 * (j))
#define XB_XSUB(j)  (1280 + 64 * (j))
#define XB_XGEN(j)  (2304 + 64 * (j))
#define XB_TOP      3328
#define XB_TOPGEN   3392
#define XCD_BAR_WORDS 3456
#define XB_LSUB(j)  (4096 + 64 * (j))
#define XB_LGEN(j)  (5120 + 64 * (j))
#define XB_SPIN_CAP (1u << 18)
__device__ __forceinline__ unsigned xb_ld(unsigned* p)              { return __hip_atomic_load(p, __ATOMIC_RELAXED, __HIP_MEMORY_SCOPE_AGENT); }
__device__ __forceinline__ unsigned xb_add(unsigned* p, unsigned v) { return __hip_atomic_fetch_add(p, v, __ATOMIC_RELAXED, __HIP_MEMORY_SCOPE_AGENT); }
__device__ __forceinline__ unsigned xb_xcc_id() { return (unsigned)__builtin_amdgcn_s_getreg((3 << 11) | 20) & 0xFu; }
#define XB_SPIN(cond, bar) do { unsigned _sp = 0; while (cond) { __builtin_amdgcn_s_sleep(1); \
    if ((++_sp & 255u) == 0u) { if (xb_ld(&(bar)[XB_TMO])) break; if (_sp > XB_SPIN_CAP) { atomicAdd(&(bar)[XB_TMO], 1u); break; } } } } while (0)
struct XcdBarrier { unsigned* bar; unsigned x; volatile LAS unsigned* st; };
__device__ __forceinline__ XcdBarrier xcd_barrier_post(unsigned* bar, volatile LAS unsigned* st) {
    XcdBarrier b; b.bar = bar; b.x = xb_xcc_id(); b.st = st;
    if (threadIdx.x == 0) st[2] = xb_add(&bar[XB_XCNT(b.x)], 1u);
    return b;
}
__device__ __forceinline__ void xcc_barrier(const XcdBarrier& b) {
    asm volatile("s_waitcnt vmcnt(0)" ::: "memory");
    __syncthreads();
    if (threadIdx.x == 0) {
        unsigned* bar = b.bar; const unsigned nloc = b.st[0];
        const unsigned old = xb_add(&bar[XB_LSUB(b.x)], 1u), gen = old / nloc;
        if (old + 1u == (gen + 1u) * nloc) xb_add(&bar[XB_LGEN(b.x)], 1u);
        else XB_SPIN(xb_ld(&bar[XB_LGEN(b.x)]) == gen, bar);
        __builtin_amdgcn_fence(__ATOMIC_ACQUIRE, "agent");
        asm volatile("s_waitcnt vmcnt(0)" ::: "memory");
    }
    __syncthreads();
}
__device__ __forceinline__ int xcc_layout(const XcdBarrier& b, int& rank, int& dense) {
    unsigned* bar = b.bar; unsigned nx = 0u, lower = 0u; bool even = true; const unsigned mine = xb_ld(&bar[XB_XCNT(b.x)]);
#pragma unroll
    for (unsigned j = 0; j < 16; ++j) { const unsigned c = xb_ld(&bar[XB_XCNT(j)]); if (c) { ++nx; if (j < b.x) ++lower; if (c != mine) even = false; } }
    rank = (int)b.st[2]; dense = (int)lower;
    return (even && nx == 8u && mine == 32u && rank < 32) ? 1 : 0;
}
__device__ __forceinline__ void xcd_barrier_complete(unsigned* bar, unsigned x, unsigned& nloc, unsigned& nx) {
    const unsigned G = gridDim.x * gridDim.y * gridDim.z;
    unsigned sum, cnt, mine, sp = 0u;
    for (;;) {
        sum = 0u; cnt = 0u; mine = 0u;
#pragma unroll
        for (unsigned j = 0; j < 16; ++j) { const unsigned c = xb_ld(&bar[XB_XCNT(j)]); sum += c; cnt += (c > 0u) ? 1u : 0u; mine = (j == x) ? c : mine; }
        if (sum == G) break;
        __builtin_amdgcn_s_sleep(1);
        if ((++sp & 255u) == 0u) { if (xb_ld(&bar[XB_TMO])) break; if (sp > XB_SPIN_CAP) { atomicAdd(&bar[XB_TMO], 1u); break; } }
    }
    nloc = mine > 0u ? mine : 1u; nx = cnt > 0u ? cnt : 1u;
}
__device__ __forceinline__ void xcd_barrier(const XcdBarrier& b) {
    asm volatile("s_waitcnt vmcnt(0)" ::: "memory");
    __syncthreads();
    if (threadIdx.x == 0) {
        unsigned* bar = b.bar;
        __builtin_amdgcn_s_waitcnt(0);
        unsigned nloc = b.st[0], nx = b.st[1];
        if (nloc == 0u) { xcd_barrier_complete(bar, b.x, nloc, nx); b.st[0] = nloc; b.st[1] = nx; }
        const unsigned old = xb_add(&bar[XB_XSUB(b.x)], 1u);
        const unsigned gen = old / nloc;
        if (old + 1u == (gen + 1u) * nloc) {
            __builtin_amdgcn_fence(__ATOMIC_RELEASE, "agent");
            asm volatile("s_waitcnt vmcnt(0)" ::: "memory");
            const unsigned og = xb_add(&bar[XB_TOP], 1u);
            const unsigned tg = og / nx;
            if (og + 1u == (tg + 1u) * nx) xb_add(&bar[XB_TOPGEN], 1u);
            else XB_SPIN(xb_ld(&bar[XB_TOPGEN]) == tg, bar);
            __builtin_amdgcn_fence(__ATOMIC_ACQUIRE, "agent");
            xb_add(&bar[XB_XGEN(b.x)], 1u);
            asm volatile("s_waitcnt vmcnt(0)" ::: "memory");
        } else {
            XB_SPIN(xb_ld(&bar[XB_XGEN(b.x)]) == gen, bar);
            __builtin_amdgcn_fence(__ATOMIC_ACQUIRE, "agent");
            asm volatile("s_waitcnt vmcnt(0)" ::: "memory");
        }
    }
    __syncthreads();
}

struct Frame {
    LAS unsigned char* lds;
    volatile LAS unsigned* MISC;
    LAS int* TAB;
    gu32* ctl;
    int tid, lane, wave;
    int vcu, G, bx, xloc;
    const float *x, *norm1_g, *w_in, *pool_w, *pool_scale, *w_pool_proj, *sinks, *w_attn_proj, *w_out, *norm2_g, *w_router, *b_router, *w_up, *b_up, *w_down, *b_down, *rel_bias, *final_g;
    float* out;
    unsigned char* ws;
};
#define WSP(T_, off) ((T_*)(F.ws + (off)))

__device__ __forceinline__ float wave_sum(float v) {
#pragma unroll
    for (int o = 1; o < 64; o <<= 1) v += __shfl_xor(v, o);
    return v;
}

template <int MAP  >
__device__ __forceinline__ void p0_transpose_item(const float* W, int N, bf16* WT, int ldt, int koff, LAS float* scr, int item, int lane) {
    const int nblk = N / 32, kb = item / nblk, nb = item % nblk, k0 = 64 * kb, n0 = 32 * nb;
    float v[32];
#pragma unroll
    for (int i = 0; i < 32; ++i) { const int kk = 2 * i + (lane >> 5); v[i] = W[(size_t)(k0 + kk) * N + n0 + (lane & 31)]; }
#pragma unroll
    for (int i = 0; i < 32; ++i) { const int kk = 2 * i + (lane >> 5); scr[kk * 33 + (lane & 31)] = v[i]; }
    LDS_WAIT(); asm volatile("" ::: "memory");
    const int c = lane & 7;
#pragma unroll
    for (int j = 0; j < 4; ++j) { const int n = (lane >> 3) + 8 * j; const LAS float* s = scr + (8 * c) * 33 + n;
        v4u o; o.x = pk2(s[0 * 33], s[1 * 33]); o.y = pk2(s[2 * 33], s[3 * 33]); o.z = pk2(s[4 * 33], s[5 * 33]); o.w = pk2(s[6 * 33], s[7 * 33]);
        int nn = n0 + n;
        if (MAP == 1) { const int pn = nn >> 8, rem = nn & 255; nn = (pn << 8) + ((rem & 1) << 7) + (rem >> 1); }
        *(GAS v4u*)(WT + (size_t)nn * ldt + koff + k0 + 8 * c) = o; }
    LDS_WAIT(); asm volatile("" ::: "memory");
}
struct Fp8Src { const float* W; int N; unsigned char* WT; int item; const float* g; int ld; };
__device__ __forceinline__ void fp8_tile_load(Frame& F, const Fp8Src& S, f32x4 (&v)[16]) {
    const int nblk = S.N / 256, kb = S.item / nblk, nb = S.item % nblk;
    const float* src = S.W + (size_t)(128 * kb + 16 * F.wave) * S.ld + 256 * nb + 4 * F.lane;
#pragma unroll
    for (int i = 0; i < 16; ++i) v[i] = __builtin_nontemporal_load((const GAS f32x4*)(src + (size_t)i * S.ld));
}
__device__ __forceinline__ void fp8_tile_pack(Frame& F, const Fp8Src& S, const f32x4 (&v)[16], v4u (&o)[4]) {
    float sc[16]; const int kr = 128 * (S.item / (S.N / 256)) + 16 * F.wave;
#pragma unroll
    for (int i = 0; i < 16; ++i) sc[i] = S.g ? S.g[kr + i] * W8_SCALE : W8_SCALE;
#pragma unroll
    for (int j = 0; j < 4; ++j)
#pragma unroll
        for (int q = 0; q < 4; ++q) o[j][q] = pk4_fp8(v[4 * q][j] * sc[4 * q], v[4 * q + 1][j] * sc[4 * q + 1], v[4 * q + 2][j] * sc[4 * q + 2], v[4 * q + 3][j] * sc[4 * q + 3]);
}
template <int MAP>
__device__ __forceinline__ void fp8_tile_store(Frame& F, const Fp8Src& S, const v4u (&o)[4]) {
    const int nblk = S.N / 256, kb = S.item / nblk, nb = S.item % nblk, k0 = 128 * kb, n0 = 256 * nb, lane = F.lane, w = F.wave;
    LAS unsigned char* tile = F.lds + RING_OFF;
    __syncthreads();
#pragma unroll
    for (int j = 0; j < 4; ++j) { const int row = 4 * lane + j; *(LAS v4u*)(tile + row * 128 + ((w ^ (lane & 7)) << 4)) = o[j]; }
    __syncthreads();
#pragma unroll
    for (int i = 0; i < 4; ++i) { const int row = (F.tid >> 3) + 64 * i, c = F.tid & 7; const v4u t = *(const LAS v4u*)(tile + row * 128 + ((c ^ ((row >> 2) & 7)) << 4));
        int nn = n0 + row; if (MAP == 1) { const int pn = nn >> 8, rem = nn & 255; nn = (pn << 8) + ((rem & 1) << 7) + (rem >> 1); }
        *(GAS v4u*)(S.WT + (size_t)nn * 1024 + k0 + 16 * c) = t; }
}
template <int WHICH>
__device__ __forceinline__ void convert_moe_w(Frame& F, int lo, int hi, int first, int nblk) {
    constexpr int NW = WHICH ? 2048 : DM, I1 = (DM / 128) * (NW / 256);
    const float* Wsrc = WHICH ? F.w_up : F.w_down; unsigned char* Wdst = WHICH ? WSP(unsigned char, WS_WUP) : WSP(unsigned char, WS_WDN);
    f32x4 v[16]; int it = lo + first;
    Fp8Src cur{nullptr, NW, nullptr, 0, WHICH ? F.norm2_g : nullptr, NW};
    if (it < hi) { const int e = it / I1; cur.W = Wsrc + (size_t)e * DM * NW; cur.WT = Wdst + (size_t)e * NW * DM; cur.item = it % I1; fp8_tile_load(F, cur, v); }
    while (it < hi) {
        v4u o[4]; fp8_tile_pack(F, cur, v, o);
        const int nx = it + nblk; Fp8Src nxt = cur;
        if (nx < hi) { const int e = nx / I1; nxt.W = Wsrc + (size_t)e * DM * NW; nxt.WT = Wdst + (size_t)e * NW * DM; nxt.item = nx % I1; fp8_tile_load(F, nxt, v); }
        fp8_tile_store<WHICH>(F, cur, o);
        cur = nxt; it = nx;
    }
    __syncthreads();
}
#ifndef DN_SPLIT
#define DN_SPLIT 384
#endif
__device__ __forceinline__ void convert_win8(Frame& F) {
    f32x4 v[16];
    for (int it = F.vcu; it < 64; it += F.G) { Fp8Src S{F.w_in + 1280, 2048, WSP(unsigned char, WS_WIN8), it, nullptr, INW};
        fp8_tile_load(F, S, v); v4u o[4]; fp8_tile_pack(F, S, v, o); fp8_tile_store<0>(F, S, o); }
    __syncthreads();
}
__device__ __forceinline__ void p0_prologue(Frame& F) {
    LAS float* scr = (LAS float*)(F.lds + RING_OFF + F.wave * 16384);
    const int gw = F.vcu * NWAVES + F.wave, NGW = F.G * NWAVES, lane = F.lane;
    bf16* Win_t = WSP(bf16, WS_WIN); bf16* Wmix_t = WSP(bf16, WS_WMIX); bf16* Wout_t = WSP(bf16, WS_WOUT); bf16* Wrt = WSP(bf16, WS_WRT);
    unsigned char* Wup_t = WSP(unsigned char, WS_WUP); bf16* H1 = WSP(bf16, WS_H1);
    if (F.wave < 4) for (int it = F.vcu * 4 + F.wave; it < 16 * 64; it += F.G * 4) {
        const int nb = it & 15, k8 = it >> 4, n = nb * 64 + lane, k0 = k8 * 8, g = k0 >> 7, kk0 = k0 & 127;
        float a[8];
#pragma unroll
        for (int i = 0; i < 8; ++i) a[i] = 0.f;
        const float* pw = F.pool_w + ((size_t)g * 128 + kk0) * 128; const float* wp = F.w_pool_proj + (size_t)(g * 128) * DM + n; const float* ps = F.pool_scale + g * 128;
#pragma unroll 1
        for (int j0 = 0; j0 < 128; j0 += 16) {
            float b[16];
#pragma unroll
            for (int j = 0; j < 16; ++j) b[j] = wp[(size_t)(j0 + j) * DM];
#pragma unroll
            for (int j = 0; j < 16; ++j) { const float bs = b[j] * ps[j0 + j];
#pragma unroll
                for (int i = 0; i < 8; ++i) a[i] += pw[i * 128 + j0 + j] * bs; }
        }
        v4u o; o.x = pk2(a[0], a[1]); o.y = pk2(a[2], a[3]); o.z = pk2(a[4], a[5]); o.w = pk2(a[6], a[7]);
        *(GAS v4u*)(Wmix_t + (size_t)n * DM + k0) = o;
    }
    constexpr int I_IN = (DM / 64) * (INW / 32), I_OUT = (DM / 64) * (DM / 32), I_AP = (512 / 64) * (DM / 32);
    constexpr int NITEMS = I_IN + I_OUT + I_AP;
    for (int it = gw; it < NITEMS; it += NGW) {
        int r = it;
        if (r < I_IN) { p0_transpose_item<0>(F.w_in, INW, Win_t, DM, 0, scr, r, lane); continue; } r -= I_IN;
        if (r < I_OUT) { p0_transpose_item<0>(F.w_out, DM, Wout_t, DM, 0, scr, r, lane); continue; } r -= I_OUT;
        p0_transpose_item<0>(F.w_attn_proj, DM, Wmix_t, DM, 512, scr, r, lane);
    }
    {
        const GAS f32x4* gp = (const GAS f32x4*)F.norm1_g + lane; f32x4 g[4];
#pragma unroll
        for (int j = 0; j < 4; ++j) g[j] = gp[64 * j];
        for (int m = gw; m < T_TOK; m += NGW) {
            const GAS f32x4* xr = (const GAS f32x4*)(F.x + (size_t)m * DM) + lane; f32x4 v[4]; float s2 = 0.f;
#pragma unroll
            for (int j = 0; j < 4; ++j) { v[j] = __builtin_nontemporal_load(xr + 64 * j); s2 += (v[j].x * v[j].x + v[j].y * v[j].y) + (v[j].z * v[j].z + v[j].w * v[j].w); }
            const float rstd = 1.f / sqrtf(wave_sum(s2) * (1.f / DM) + RMS_EPS);
            GAS unsigned long long* o8 = (GAS unsigned long long*)(H1 + (size_t)m * DM) + lane; GAS unsigned* o4 = (GAS unsigned*)(WSP(unsigned char, WS_H18) + (size_t)m * DM) + lane;
#pragma unroll
            for (int j = 0; j < 4; ++j) { const float h0 = v[j].x * rstd * g[j].x, h1v = v[j].y * rstd * g[j].y, h2 = v[j].z * rstd * g[j].z, h3 = v[j].w * rstd * g[j].w;
                o8[64 * j] = (unsigned long long)pk2(h0, h1v) | ((unsigned long long)pk2(h2, h3) << 32); o4[64 * j] = pk4_fp8(h0, h1v, h2, h3); }
        }
    }
    convert_win8(F);
    for (int it = gw * 64 + lane; it < 32 * 128; it += NGW * 64) {
        const int e = it & 31, k0 = (it >> 5) * 8; unsigned hi[4], lo[4];
#pragma unroll
        for (int i = 0; i < 4; ++i) { const float v0 = F.w_router[(size_t)(k0 + 2 * i) * NEXP + e] * F.norm2_g[k0 + 2 * i], v1 = F.w_router[(size_t)(k0 + 2 * i + 1) * NEXP + e] * F.norm2_g[k0 + 2 * i + 1];
            hi[i] = pk2(v0, v1); lo[i] = pk2(v0 - bf_lo(hi[i]), v1 - bf_hi(hi[i])); }
        *(GAS v4u*)(Wrt + (size_t)e * DM + k0) = (v4u){hi[0], hi[1], hi[2], hi[3]};
        *(GAS v4u*)(Wrt + (size_t)(NEXP + e) * DM + k0) = (v4u){lo[0], lo[1], lo[2], lo[3]};
    }
}

struct ProbDense {
    static constexpr bool GATHER = false, FP8 = false;
    const char* A; const char* Bt;
    __device__ __forceinline__ const char* a_tile(const pg8::Unit& u) const { return A + (size_t)u.pm * (256 * 2048); }
    __device__ __forceinline__ const char* b_tile(const pg8::Unit& u) const { return Bt + (size_t)u.pn * (256 * 2048); }
    __device__ __forceinline__ unsigned a_rowoff(const pg8::Unit&, int) const { return 0u; }
};
struct ProbDense8 {
    static constexpr bool GATHER = false, FP8 = true;
    const char* A; const char* Bt;
    __device__ __forceinline__ const char* a_tile(const pg8::Unit& u) const { return A + (size_t)u.pm * (256 * 1024); }
    __device__ __forceinline__ const char* b_tile(const pg8::Unit& u) const { return Bt + (size_t)u.pn * (256 * 1024); }
    __device__ __forceinline__ unsigned a_rowoff(const pg8::Unit&, int) const { return 0u; }
};
struct P1Order {
    static constexpr bool WAITS = false, PUBLISHES = false;
    int x, r, fp8;
    __host__ __device__ bool next(int i, pg8::Unit& u) const {
        int j;
        if (!fp8) { if (i == 0) j = r; else if (i == 1 && r < 8) j = 32 + r; else return false; }
        else { if (r < 8) { if (i) return false; j = r; } else { j = r + 24 * i; if (i > 2 || j >= 64) return false; } }
        u.pm = 8 * x + (j & 7); u.pn = j >> 3; return true;
    }
};
struct ProbUp {
    static constexpr bool GATHER = true, FP8 = true;
    const char* A; const char* Bt; const int* ltok; const LAS int* TAB;
    __device__ __forceinline__ const char* a_tile(const pg8::Unit&) const { return A; }
    __device__ __forceinline__ const char* b_tile(const pg8::Unit& u) const { const int e = __builtin_amdgcn_readfirstlane(TAB[72 + u.pm]); return Bt + ((size_t)e * 2048 + (size_t)u.pn * 256) * 1024; }
    __device__ __forceinline__ unsigned a_rowoff(const pg8::Unit& u, int r) const {
        const int e = __builtin_amdgcn_readfirstlane(TAB[72 + u.pm]), pos = (u.pm - __builtin_amdgcn_readfirstlane(TAB[32 + e])) * 256 + r, cnt = __builtin_amdgcn_readfirstlane(TAB[e]);
        return (unsigned)ltok[e * CAP + (pos < cnt ? pos : 0)]; }
};
struct ProbDown {
    static constexpr bool GATHER = false, FP8 = true;
    const char* A; const char* Bt; const LAS int* TAB;
    __device__ __forceinline__ const char* a_tile(const pg8::Unit& u) const { return A + (size_t)u.pm * (256 * 1024); }
    __device__ __forceinline__ const char* b_tile(const pg8::Unit& u) const { const int e = __builtin_amdgcn_readfirstlane(TAB[72 + u.pm]); return Bt + ((size_t)e * 1024 + (size_t)u.pn * 256) * 1024; }
    __device__ __forceinline__ unsigned a_rowoff(const pg8::Unit&, int) const { return 0u; }
};

using pg8::f32x2; using pg8::u32x4;
struct NoPre {};
struct EpiInProj {
    static constexpr bool PERM = true, PREFETCH = false; static constexpr int MID = 0; typedef NoPre Pre;
    bf16 *U, *Q, *KV, *GP, *GA;
    __device__ __forceinline__ void mid(pg8::f32x4 (&)[2][2][4][2], const pg8::Unit&, int, int, int, int) const {}
    __device__ __forceinline__ void operator()(const pg8::f32x4 (&acc)[2][2][4][2], const NoPre&, const pg8::Unit& u, int wr, int wc, int fr, int fq) const {
        bf16* base; int ldc; float sc = 1.f; const int pn = u.pn;
        if (pn < 2) { base = U + pn * 256; ldc = 512; } else if (pn < 4) { base = Q + (pn - 2) * 256; ldc = 512; sc = 0.125f; } else if (pn == 4) { base = KV; ldc = 256; }
        else if (pn < 9) { base = GP + (pn - 5) * 256; ldc = 1024; } else { base = GA + (pn - 9) * 256; ldc = 1024; }
        const int row0 = u.pm * 256 + wr * 64 + fr, col0 = wc * 32 + 8 * fq;
#pragma unroll
        for (int ai = 0; ai < 2; ++ai)
#pragma unroll
            for (int m = 0; m < 4; ++m) { bf16* rowp = base + (size_t)(row0 + ai * 128 + m * 16) * ldc + col0;
#pragma unroll
                for (int bj = 0; bj < 2; ++bj) { const pg8::f32x4 v0 = acc[ai][bj][m][0] * sc, v1 = acc[ai][bj][m][1] * sc;
                    u32x4 w; w.x = cvt_pk_bf16(v0[0], v0[1]); w.y = cvt_pk_bf16(v0[2], v0[3]); w.z = cvt_pk_bf16(v1[0], v1[1]); w.w = cvt_pk_bf16(v1[2], v1[3]);
                    *(u32x4*)(rowp + bj * 128) = w; } }
    }
};
struct EpiGate8 {
    static constexpr bool PERM = true, PREFETCH = false; static constexpr int MID = 0; typedef NoPre Pre;
    unsigned char *GP, *GA;
    __device__ __forceinline__ void mid(pg8::f32x4 (&)[2][2][4][2], const pg8::Unit&, int, int, int, int) const {}
    __device__ __forceinline__ void operator()(const pg8::f32x4 (&acc)[2][2][4][2], const NoPre&, const pg8::Unit& u, int wr, int wc, int fr, int fq) const {
        unsigned char* base = (u.pn < 4) ? GP + u.pn * 256 : GA + (u.pn - 4) * 256;
        const int row0 = u.pm * 256 + wr * 64 + fr, col0 = wc * 32 + 8 * fq;
#pragma unroll
        for (int ai = 0; ai < 2; ++ai)
#pragma unroll
            for (int m = 0; m < 4; ++m) { unsigned char* rowp = base + (size_t)(row0 + ai * 128 + m * 16) * 1024 + col0;
#pragma unroll
                for (int bj = 0; bj < 2; ++bj) { const pg8::f32x4 v0 = acc[ai][bj][m][0] * W8_INV, v1 = acc[ai][bj][m][1] * W8_INV;
                    v2u w; w.x = pk4_fp8(v0[0], v0[1], v0[2], v0[3]); w.y = pk4_fp8(v1[0], v1[1], v1[2], v1[3]);
                    *(v2u*)(rowp + bj * 128) = w; } }
    }
};
__device__ __forceinline__ float clampf(float x, float lo, float hi) { return fminf(fmaxf(x, lo), hi); }
__device__ __forceinline__ float en(float x) { return __builtin_amdgcn_exp2f(-LOG2E * clampf(x, -80.f, 80.f)); }
struct EpiMix {
    static constexpr bool PERM = true, PREFETCH = false; static constexpr int MID = 8; typedef NoPre Pre;
    const unsigned char *GP, *GA; bf16* MIX;
    static __device__ __forceinline__ void dec8(v2u w, float (&x)[8]) {
        const f32x2_t a = __builtin_amdgcn_cvt_pk_f32_fp8((int)w.x, false), b = __builtin_amdgcn_cvt_pk_f32_fp8((int)w.x, true), c = __builtin_amdgcn_cvt_pk_f32_fp8((int)w.y, false), d = __builtin_amdgcn_cvt_pk_f32_fp8((int)w.y, true);
        x[0] = a[0]; x[1] = a[1]; x[2] = b[0]; x[3] = b[1]; x[4] = c[0]; x[5] = c[1]; x[6] = d[0]; x[7] = d[1]; }
    __device__ __forceinline__ void mid(pg8::f32x4 (&acc)[2][2][4][2], const pg8::Unit& u, int wr, int wc, int fr, int fq) const {
        const unsigned off0 = (unsigned)(u.pm * 256 + wr * 64 + fr) * 1024u + (unsigned)(u.pn * 256 + wc * 32 + 8 * fq);
#pragma unroll
        for (int ai = 0; ai < 2; ++ai) {
            v2u p[4][2], a[4][2];
#pragma unroll
            for (int m = 0; m < 4; ++m)
#pragma unroll
                for (int bj = 0; bj < 2; ++bj) { const unsigned off = off0 + (unsigned)((ai * 128 + m * 16) * 1024 + bj * 128); p[m][bj] = *(const v2u*)(GP + off); a[m][bj] = *(const v2u*)(GA + off); }
#pragma unroll
            for (int m = 0; m < 4; ++m)
#pragma unroll
                for (int bj = 0; bj < 2; ++bj) { float xp[8], xa[8]; dec8(p[m][bj], xp); dec8(a[m][bj], xa);
#pragma unroll
                    for (int c = 0; c < 8; ++c) acc[ai][bj][m][c >> 2][c & 3] *= (1.f + en(xa[c])) * __builtin_amdgcn_rcpf(1.f + en(xp[c]));
                    asm volatile("" : "+v"(acc[ai][bj][m][0]), "+v"(acc[ai][bj][m][1])); }
            asm volatile("" ::: "memory");
        }
    }
    __device__ __forceinline__ void operator()(const pg8::f32x4 (&acc)[2][2][4][2], const NoPre&, const pg8::Unit& u, int wr, int wc, int fr, int fq) const {
        const unsigned off0 = (unsigned)(u.pm * 256 + wr * 64 + fr) * 1024u + (unsigned)(u.pn * 256 + wc * 32 + 8 * fq);
        v2u a[2][4][2];
#pragma unroll
        for (int ai = 0; ai < 2; ++ai)
#pragma unroll
            for (int m = 0; m < 4; ++m)
#pragma unroll
                for (int bj = 0; bj < 2; ++bj) a[ai][m][bj] = *(const v2u*)(GA + off0 + (unsigned)((ai * 128 + m * 16) * 1024 + bj * 128));
#pragma unroll
        for (int ai = 0; ai < 2; ++ai)
#pragma unroll
            for (int m = 0; m < 4; ++m)
#pragma unroll
                for (int bj = 0; bj < 2; ++bj) { float xa[8], sg[8]; dec8(a[ai][m][bj], xa);
#pragma unroll
                    for (int c = 0; c < 8; ++c) sg[c] = __builtin_amdgcn_rcpf(1.f + en(xa[c]));
                    const pg8::f32x4 v0 = acc[ai][bj][m][0], v1 = acc[ai][bj][m][1];
                    u32x4 w; w.x = cvtpk_s(v0[0] * sg[0], v0[1] * sg[1]); w.y = cvtpk_s(v0[2] * sg[2], v0[3] * sg[3]); w.z = cvtpk_s(v1[0] * sg[4], v1[1] * sg[5]); w.w = cvtpk_s(v1[2] * sg[6], v1[3] * sg[7]);
                    *(u32x4*)(MIX + off0 + (unsigned)((ai * 128 + m * 16) * 1024 + bj * 128)) = w; }
    }
};
struct EpiOut {
    static constexpr bool PERM = true, PREFETCH = false; static constexpr int MID = 0; typedef NoPre Pre;
    const float* X; bf16* X1;
    __device__ __forceinline__ void mid(pg8::f32x4 (&)[2][2][4][2], const pg8::Unit&, int, int, int, int) const {}
    __device__ __forceinline__ void operator()(const pg8::f32x4 (&acc)[2][2][4][2], const NoPre&, const pg8::Unit& u, int wr, int wc, int fr, int fq) const {
        const unsigned off0 = (unsigned)(u.pm * 256 + wr * 64 + fr) * 1024u + (unsigned)(u.pn * 256 + wc * 32 + 8 * fq);
#pragma unroll
        for (int ai = 0; ai < 2; ++ai) {
            pg8::f32x4 xv[4][2][2];
#pragma unroll
            for (int m = 0; m < 4; ++m)
#pragma unroll
                for (int bj = 0; bj < 2; ++bj)
#pragma unroll
                    for (int n = 0; n < 2; ++n) xv[m][bj][n] = *(const pg8::f32x4*)(X + off0 + (unsigned)((ai * 128 + m * 16) * 1024 + bj * 128 + n * 4));
#pragma unroll
            for (int m = 0; m < 4; ++m)
#pragma unroll
                for (int bj = 0; bj < 2; ++bj) { const pg8::f32x4 v0 = xv[m][bj][0] + acc[ai][bj][m][0], v1 = xv[m][bj][1] + acc[ai][bj][m][1];
                    u32x4 w; w.x = cvtpk_s(v0[0], v0[1]); w.y = cvtpk_s(v0[2], v0[3]); w.z = cvtpk_s(v1[0], v1[1]); w.w = cvtpk_s(v1[2], v1[3]);
                    *(u32x4*)(X1 + off0 + (unsigned)((ai * 128 + m * 16) * 1024 + bj * 128)) = w; }
            asm volatile("" ::: "memory");
        }
    }
};
struct EpiUp {
    static constexpr bool PERM = true, PREFETCH = true; static constexpr int MID = 0;
    struct Pre { pg8::f32x4 bq[4]; float rsv[2][4]; };
    const float* b_up; const float* lrstd; unsigned char* ACT; const LAS int* TAB;
    __device__ __forceinline__ void prefetch(Pre& p, const pg8::Unit& u, int wr, int wc, int fr, int fq) const {
        const int e = __builtin_amdgcn_readfirstlane(TAB[72 + u.pm]), pos0 = (u.pm - __builtin_amdgcn_readfirstlane(TAB[32 + e])) * 256, cnt = __builtin_amdgcn_readfirstlane(TAB[e]);
        const int rl0 = wr * 64 + fr, cc0 = wc * 32 + 8 * fq;
        const float* bp = b_up + (size_t)e * 2048 + 2 * (128 * u.pn + cc0);
#pragma unroll
        for (int q = 0; q < 4; ++q) p.bq[q] = *(const pg8::f32x4*)(bp + 4 * q);
#pragma unroll
        for (int ai = 0; ai < 2; ++ai)
#pragma unroll
            for (int m = 0; m < 4; ++m) { const int pos = pos0 + rl0 + ai * 128 + m * 16; p.rsv[ai][m] = lrstd[e * CAP + (pos < cnt ? pos : 0)]; }
    }
    __device__ __forceinline__ void mid(pg8::f32x4 (&)[2][2][4][2], const pg8::Unit&, int, int, int, int) const {}
    __device__ __forceinline__ void operator()(const pg8::f32x4 (&acc)[2][2][4][2], const Pre& pre, const pg8::Unit& u, int wr, int wc, int fr, int fq) const {
        const int e = __builtin_amdgcn_readfirstlane(TAB[72 + u.pm]), pos0 = (u.pm - __builtin_amdgcn_readfirstlane(TAB[32 + e])) * 256, cnt = __builtin_amdgcn_readfirstlane(TAB[e]);
        const int rl0 = wr * 64 + fr, cc0 = wc * 32 + 8 * fq;
        const pg8::f32x4 (&bq)[4] = pre.bq; float rsv[2][4];
#pragma unroll
        for (int ai = 0; ai < 2; ++ai)
#pragma unroll
            for (int m = 0; m < 4; ++m) rsv[ai][m] = (pos0 + rl0 + ai * 128 + m * 16) < cnt ? pre.rsv[ai][m] * W8_INV : 0.f;
        f32x2 bg[4], bl[4];
#pragma unroll
        for (int q = 0; q < 4; ++q) { bg[q] = (f32x2){bq[q][0], bq[q][2]}; bl[q] = (f32x2){bq[q][1], bq[q][3]}; }
        constexpr float KS = -1.702f * LOG2E;
#pragma unroll
        for (int ai = 0; ai < 2; ++ai)
#pragma unroll
            for (int m = 0; m < 4; ++m) { const int rl = rl0 + ai * 128 + m * 16; const float rs = rsv[ai][m]; const f32x2 rs2 = (f32x2){rs, rs};
                unsigned pk[4];
#pragma unroll
                for (int p = 0; p < 4; ++p) { const int n = p >> 1, i = (p & 1) * 2;
                    f32x2 g = (f32x2){acc[ai][0][m][n][i], acc[ai][0][m][n][i + 1]} * rs2 + bg[p], l = (f32x2){acc[ai][1][m][n][i], acc[ai][1][m][n][i + 1]} * rs2 + bl[p];
                    g.x = fminf(g.x, 7.0f); g.y = fminf(g.y, 7.0f); l.x = __builtin_amdgcn_fmed3f(l.x, -7.0f, 7.0f); l.y = __builtin_amdgcn_fmed3f(l.y, -7.0f, 7.0f);
                    const f32x2 t = g * KS; f32x2 ex; ex.x = __builtin_amdgcn_exp2f(t.x); ex.y = __builtin_amdgcn_exp2f(t.y);
                    const f32x2 d = ex + 1.0f; f32x2 sg; sg.x = __builtin_amdgcn_rcpf(d.x); sg.y = __builtin_amdgcn_rcpf(d.y);
                    const f32x2 o = g * sg, r = o * l + o;
                    pk[p] = (unsigned)__builtin_amdgcn_cvt_pk_fp8_f32(r.x, r.y, 0, false) & 0xffffu; }
                v2u w; w.x = pk[0] | (pk[1] << 16); w.y = pk[2] | (pk[3] << 16);
                *(v2u*)(ACT + (size_t)(u.pm * 256 + rl) * 1024 + 128 * u.pn + cc0) = w; }
    }
};
struct EpiDown {
    static constexpr bool PERM = true, PREFETCH = true; static constexpr int MID = 0;
    struct Pre { pg8::f32x4 bv[2][2]; float gtv[2][4]; };
    const float* b_dn; const float* lgate; unsigned char* Y; const LAS int* TAB;
    __device__ __forceinline__ void prefetch(Pre& p, const pg8::Unit& u, int wr, int wc, int fr, int fq) const {
        const int e = __builtin_amdgcn_readfirstlane(TAB[72 + u.pm]), pos0 = (u.pm - __builtin_amdgcn_readfirstlane(TAB[32 + e])) * 256, cnt = __builtin_amdgcn_readfirstlane(TAB[e]);
        const int rl0 = wr * 64 + fr, col0 = u.pn * 256 + wc * 32 + 8 * fq;
#pragma unroll
        for (int bj = 0; bj < 2; ++bj)
#pragma unroll
            for (int n = 0; n < 2; ++n) p.bv[bj][n] = *(const pg8::f32x4*)(b_dn + (size_t)e * 1024 + col0 + bj * 128 + 4 * n);
#pragma unroll
        for (int ai = 0; ai < 2; ++ai)
#pragma unroll
            for (int m = 0; m < 4; ++m) { const int pos = pos0 + rl0 + ai * 128 + m * 16; p.gtv[ai][m] = lgate[e * CAP + (pos < cnt ? pos : 0)]; }
    }
    __device__ __forceinline__ void mid(pg8::f32x4 (&)[2][2][4][2], const pg8::Unit&, int, int, int, int) const {}
    __device__ __forceinline__ void operator()(const pg8::f32x4 (&acc)[2][2][4][2], const Pre& pre, const pg8::Unit& u, int wr, int wc, int fr, int fq) const {
        const int e = __builtin_amdgcn_readfirstlane(TAB[72 + u.pm]), pos0 = (u.pm - __builtin_amdgcn_readfirstlane(TAB[32 + e])) * 256, cnt = __builtin_amdgcn_readfirstlane(TAB[e]);
        const int rl0 = wr * 64 + fr, col0 = u.pn * 256 + wc * 32 + 8 * fq;
        const pg8::f32x4 (&bv)[2][2] = pre.bv; float gtv[2][4];
#pragma unroll
        for (int ai = 0; ai < 2; ++ai)
#pragma unroll
            for (int m = 0; m < 4; ++m) gtv[ai][m] = (pos0 + rl0 + ai * 128 + m * 16) < cnt ? pre.gtv[ai][m] : 0.f;
#pragma unroll
        for (int ai = 0; ai < 2; ++ai)
#pragma unroll
            for (int m = 0; m < 4; ++m) { const int rl = rl0 + ai * 128 + m * 16; const float gt = gtv[ai][m], gs = gt * W8_INV;
                unsigned char* rowp = Y + (size_t)(u.pm * 256 + rl) * 1024 + col0;
#pragma unroll
                for (int bj = 0; bj < 2; ++bj) { const pg8::f32x4 v0 = acc[ai][bj][m][0] * gs + bv[bj][0] * gt, v1 = acc[ai][bj][m][1] * gs + bv[bj][1] * gt;
                    v2u w; w.x = pk4_fp8(v0[0], v0[1], v0[2], v0[3]); w.y = pk4_fp8(v1[0], v1[1], v1[2], v1[3]);
                    *(v2u*)(rowp + bj * 128) = w; } }
    }
};

__device__ const unsigned char T5_BUCKET[128] = {0, 1, 2, 3, 4, 5, 6, 7, 8, 9, 10, 11, 12, 13, 14, 15, 16, 16, 16, 17, 17, 18, 18, 18, 19, 19, 19, 20, 20, 20, 20, 21, 21, 21, 21, 22, 22, 22, 22, 22, 23, 23, 23, 23, 23, 23, 24, 24, 24, 24, 24, 24, 25, 25, 25, 25, 25, 25, 25, 26, 26, 26, 26, 26, 26, 26, 26, 27, 27, 27, 27, 27, 27, 27, 27, 27, 27, 28, 28, 28, 28, 28, 28, 28, 28, 28, 28, 29, 29, 29, 29, 29, 29, 29, 29, 29, 29, 29, 29, 30, 30, 30, 30, 30, 30, 30, 30, 30, 30, 30, 30, 30, 30, 31, 31, 31, 31, 31, 31, 31, 31, 31, 31, 31, 31, 31, 31, 31};
constexpr int KS_PITCH = 144, VT_PITCH = 520;
constexpr int ATT_KS = 0, ATT_VT = 256 * KS_PITCH, ATT_BIAS = ATT_VT + 64 * VT_PITCH;
static_assert(ATT_BIAS + 4 * 128 * 4 <= RING_BYTES, "attention LDS");
__device__ __forceinline__ int crow(int i, int hi) { return (i & 3) + 8 * (i >> 2) + 4 * hi; }
__device__ __forceinline__ void attn_unit(Frame& F, int b, int nblk, int kvh) {
    const bf16* Q = WSP(bf16, WS_Q); const bf16* KV = WSP(bf16, WS_KV); bf16* ZA = WSP(bf16, WS_ZA);
    LAS unsigned char* ks = F.lds + RING_OFF + ATT_KS; LAS unsigned char* vt = F.lds + RING_OFF + ATT_VT; LAS float* bias2 = (LAS float*)(F.lds + RING_OFF + ATT_BIAS);
    const int tid = F.tid, lane = F.lane, w = F.wave;
    const int kpos0 = (nblk - 1) * 128;
    bf16x8 qfa[2][4];
    { const int g_ = w >> 1, qh_ = kvh * 4 + g_, ql_ = lane & 31, hi_ = lane >> 5;
#pragma unroll
      for (int qt2 = 0; qt2 < 2; ++qt2) { const size_t tq_ = (size_t)b * SEQ + nblk * 128 + 32 * (2 * (w & 1) + qt2) + ql_;
#pragma unroll
          for (int s2 = 0; s2 < 4; ++s2) qfa[qt2][s2] = *(const GAS bf16x8*)(Q + tq_ * 512 + qh_ * 64 + s2 * 16 + hi_ * 8); } }
    __syncthreads();
#pragma unroll
    for (int i = 0; i < 4; ++i) {
        const int c = tid + 512 * i, row = c >> 3, part = c & 7; const int kp = kpos0 + row;
        v4u kk = (v4u){0u, 0u, 0u, 0u}, vv = (v4u){0u, 0u, 0u, 0u};
        if (kp >= 0) { const bf16* src = KV + (size_t)(b * SEQ + kp) * 256 + kvh * 64 + part * 8; kk = *(const GAS v4u*)src; vv = *(const GAS v4u*)(src + 128); }
        *(LAS v4u*)(ks + row * KS_PITCH + part * 16) = kk;
        LAS unsigned short* vd = (LAS unsigned short*)(vt + (part * 8) * VT_PITCH + row * 2);
#pragma unroll
        for (int j = 0; j < 4; ++j) { vd[(2 * j) * (VT_PITCH / 2)] = (unsigned short)(vv[j] & 0xffffu); vd[(2 * j + 1) * (VT_PITCH / 2)] = (unsigned short)(vv[j] >> 16); }
    }
    { const int g = tid >> 7, d = tid & 127; bias2[tid] = F.rel_bias[(int)T5_BUCKET[d] * 8 + kvh * 4 + g] * LOG2E; }
    __syncthreads();
    const int g = w >> 1, qh = kvh * 4 + g, ql = lane & 31, hi = lane >> 5;
    const float sink2 = F.sinks[qh] * LOG2E;
#pragma unroll 1
    for (int qt2 = 0; qt2 < 2; ++qt2) {
        const int q0 = 32 * (2 * (w & 1) + qt2), qi = q0 + ql; const size_t tq = (size_t)b * SEQ + nblk * 128 + qi;
        bf16x8 qf[4];
#pragma unroll
        for (int s = 0; s < 4; ++s) qf[s] = qt2 ? qfa[1][s] : qfa[0][s];
        f32x16 sc[5];
#pragma unroll
        for (int kt = 0; kt < 5; ++kt) {
            f32x16 a;
#pragma unroll
            for (int i = 0; i < 16; ++i) a[i] = 0.f;
            const int kb = q0 + 32 * kt;
#pragma unroll
            for (int s = 0; s < 4; ++s) { const bf16x8 kf = *(const LAS bf16x8*)(ks + (kb + ql) * KS_PITCH + s * 32 + hi * 16); a = __builtin_amdgcn_mfma_f32_32x32x16_bf16(kf, qf[s], a, 0, 0, 0); }
            sc[kt] = a;
        }
        float mx = sink2;
#pragma unroll
        for (int kt = 0; kt < 5; ++kt)
#pragma unroll
            for (int i = 0; i < 16; ++i) { const int kj = q0 + 32 * kt + crow(i, hi), dist = 128 + qi - kj; const bool ok = (dist >= 0) && (dist < 128) && (kpos0 + kj >= 0);
                const float s = ok ? sc[kt][i] * LOG2E + bias2[g * 128 + (dist & 127)] : -1e30f; sc[kt][i] = s; mx = fmaxf(mx, s); }
        mx = fmaxf(mx, __shfl_xor(mx, 32));
        float l = 0.f;
#pragma unroll
        for (int kt = 0; kt < 5; ++kt)
#pragma unroll
            for (int i = 0; i < 16; ++i) { const float p = __builtin_amdgcn_exp2f(sc[kt][i] - mx); sc[kt][i] = p; l += p; }
        l += __shfl_xor(l, 32); l += __builtin_amdgcn_exp2f(sink2 - mx);
        const float inv = 1.f / l;
        f32x16 o[2];
#pragma unroll
        for (int dt = 0; dt < 2; ++dt)
#pragma unroll
            for (int i = 0; i < 16; ++i) o[dt][i] = 0.f;
#pragma unroll
        for (int kt = 0; kt < 5; ++kt)
#pragma unroll
            for (int ss = 0; ss < 2; ++ss) {
                v4u pw;
#pragma unroll
                for (int j = 0; j < 4; ++j) pw[j] = cvt_pk_bf16(sc[kt][8 * ss + 2 * j], sc[kt][8 * ss + 2 * j + 1]);
                const bf16x8 pf = __builtin_bit_cast(bf16x8, pw);
                const int kv0 = q0 + 32 * kt + 16 * ss + 4 * hi;
#pragma unroll
                for (int dt = 0; dt < 2; ++dt) { const LAS unsigned char* vp = vt + (dt * 32 + ql) * VT_PITCH + kv0 * 2;
                    const v2u v0 = *(const LAS v2u*)vp, v1 = *(const LAS v2u*)(vp + 16); const v4u vw = (v4u){v0.x, v0.y, v1.x, v1.y};
                    o[dt] = __builtin_amdgcn_mfma_f32_32x32x16_bf16(__builtin_bit_cast(bf16x8, vw), pf, o[dt], 0, 0, 0); }
            }
        bf16* orow = ZA + tq * 1024 + 512 + qh * 64;
#pragma unroll
        for (int dt = 0; dt < 2; ++dt)
#pragma unroll
            for (int q4 = 0; q4 < 4; ++q4) { v2u ww; ww.x = cvt_pk_bf16(o[dt][4 * q4] * inv, o[dt][4 * q4 + 1] * inv); ww.y = cvt_pk_bf16(o[dt][4 * q4 + 2] * inv, o[dt][4 * q4 + 3] * inv);
                *(GAS v2u*)(orow + dt * 32 + 8 * q4 + 4 * hi) = ww; }
    }
}
__device__ __forceinline__ void p2_attn_pool(Frame& F) {
    for (int uidx = F.vcu; uidx < NB * 32 * 2; uidx += F.G) { const int kvh = uidx & 1, nblk = (uidx >> 1) & 31, b = uidx >> 6; attn_unit(F, b, nblk, kvh); }
    const bf16* U = WSP(bf16, WS_U); bf16* ZA = WSP(bf16, WS_ZA);
    for (int it = F.vcu * NWAVES + F.wave; it < T_TOK / 8; it += F.G * NWAVES) {
        const int t0 = it * 8, c8 = F.lane, g = c8 >> 4, wnd = 2 << g, pos0 = t0 & (SEQ - 1);
        const bf16* up = U + (size_t)t0 * 512 + c8 * 8;
        v4u ur[23];
#pragma unroll
        for (int j = 0; j < 23; ++j) { const int rel = j - 15; ur[j] = (v4u){0u, 0u, 0u, 0u}; if (rel > -wnd && pos0 + rel >= 0) ur[j] = *(const GAS v4u*)(up + (ptrdiff_t)rel * 512); }
#pragma unroll
        for (int i = 0; i < 8; ++i) {
            const int pos = pos0 + i, cnt = (pos + 1) < wnd ? (pos + 1) : wnd;
            float sacc[8];
#pragma unroll
            for (int q = 0; q < 4; ++q) { sacc[2 * q] = bf_lo(ur[15 + i][q]); sacc[2 * q + 1] = bf_hi(ur[15 + i][q]); }
#pragma unroll
            for (int j = 1; j < 16; ++j) { const bool on = j < cnt;
#pragma unroll
                for (int q = 0; q < 4; ++q) { const unsigned wv = ur[15 + i - j][q]; sacc[2 * q] += on ? bf_lo(wv) : 0.f; sacc[2 * q + 1] += on ? bf_hi(wv) : 0.f; } }
            const float ic = 1.0f / (float)cnt; v4u o;
#pragma unroll
            for (int q = 0; q < 4; ++q) o[q] = cvtpk_s(sacc[2 * q] * ic - bf_lo(ur[15 + i][q]), sacc[2 * q + 1] * ic - bf_hi(ur[15 + i][q]));
            *(GAS v4u*)(ZA + (size_t)(t0 + i) * 1024 + c8 * 8) = o;
        }
    }
}

constexpr int P5_OFF = 133120;
static_assert(P5_OFF >= TAB_OFF + (32 + 40 + NRT_MAX) * 4 && P5_OFF + 4 * 2304 + 256 <= LDS_BYTES, "router scratch");
__device__ __forceinline__ void p5_router(Frame& F) {
    const bf16* X1 = WSP(bf16, WS_X1); unsigned char* H2 = WSP(unsigned char, WS_H2); const char* Wg = (const char*)WSP(bf16, WS_WRT);
    int* ltok = WSP(int, WS_LTOK); float* lgate = WSP(float, WS_LGATE); float* lrstd = WSP(float, WS_LRSTD); int* toke = WSP(int, WS_TOKE); int* tokp = WSP(int, WS_TOKP);
    int lane = F.lane; asm volatile("" : "+v"(lane));
    const int w = F.wave, r = lane & 15, q = lane >> 4, rg = w;
    LAS float* lg = (LAS float*)(F.lds + P5_OFF + (rg & 3) * 2304);
    LAS int* lcnt = (LAS int*)(F.lds + P5_OFF + 4 * 2304); LAS int* lbase = lcnt + 32;
    const LAS unsigned char* wl = F.lds + RING_OFF;
    const unsigned lds0 = (unsigned)(uintptr_t)(F.lds + RING_OFF);
    for (int tb = F.vcu; tb < T_TOK / 64; tb += F.G) {
        __syncthreads();
        if (F.tid < 32) lcnt[F.tid] = 0;
        int pe[4] = {0, 0, 0, 0}, pl[4] = {0, 0, 0, 0}; float pw[4] = {0.f, 0.f, 0.f, 0.f}; float rstd = 0.f;
        const int row0 = tb * 64 + (rg & 3) * 16;
        bf16x8 xr[32];
        if (w < 4) { const bf16* xp = X1 + (size_t)(row0 + r) * 1024 + 8 * q;
#pragma unroll
            for (int s2 = 0; s2 < 32; ++s2) xr[s2] = *(const GAS bf16x8*)(xp + 32 * s2); }
#pragma unroll
        for (int j = 0; j < 16; ++j) { const int p = w * 16 + j, R = p >> 1, cd = (p & 1) * 64 + lane;
            pg8::glds16s(Wg, (unsigned)(R * 2048 + ((cd ^ ((R & 3) << 2)) << 4)), lds0 + (unsigned)p * 1024u); }
        asm volatile("s_waitcnt vmcnt(0)" ::: "memory");
        __syncthreads();
        if (w < 4) {
            pg8::f32x4 a0 = (pg8::f32x4){0.f, 0.f, 0.f, 0.f}, a1 = a0; float ss = 0.f;
            unsigned char* hp = H2 + (size_t)(row0 + r) * 1024 + 8 * q;
            const LAS unsigned char* wb = wl + r * 2048; const int sw = (r & 3) << 2;
#pragma unroll
            for (int s2 = 0; s2 < 32; ++s2) {
                const v4u xw = __builtin_bit_cast(v4u, xr[s2]);
                const pg8::f32x4 xa = (pg8::f32x4){bf_lo(xw[0]), bf_hi(xw[0]), bf_lo(xw[1]), bf_hi(xw[1])}, xb = (pg8::f32x4){bf_lo(xw[2]), bf_hi(xw[2]), bf_lo(xw[3]), bf_hi(xw[3])};
                ss += (xa[0] * xa[0] + xa[1] * xa[1]) + (xa[2] * xa[2] + xa[3] * xa[3]) + (xb[0] * xb[0] + xb[1] * xb[1]) + (xb[2] * xb[2] + xb[3] * xb[3]);
                { v2u h8; h8.x = pk4_fp8(xa[0], xa[1], xa[2], xa[3]); h8.y = pk4_fp8(xb[0], xb[1], xb[2], xb[3]); *(GAS v2u*)(hp + 32 * s2) = h8; }
                const int co = ((4 * s2 + q) ^ sw) << 4;
                const bf16x8 bh0 = *(const LAS bf16x8*)(wb + co), bh1 = *(const LAS bf16x8*)(wb + 16 * 2048 + co), bl0 = *(const LAS bf16x8*)(wb + 32 * 2048 + co), bl1 = *(const LAS bf16x8*)(wb + 48 * 2048 + co);
                a0 = __builtin_amdgcn_mfma_f32_16x16x32_bf16(xr[s2], bh0, a0, 0, 0, 0); a1 = __builtin_amdgcn_mfma_f32_16x16x32_bf16(xr[s2], bh1, a1, 0, 0, 0);
                a0 = __builtin_amdgcn_mfma_f32_16x16x32_bf16(xr[s2], bl0, a0, 0, 0, 0); a1 = __builtin_amdgcn_mfma_f32_16x16x32_bf16(xr[s2], bl1, a1, 0, 0, 0);
            }
            ss += __shfl_xor(ss, 16); ss += __shfl_xor(ss, 32);
            rstd = 1.f / sqrtf(ss * (1.f / DM) + RMS_EPS);
            const float b0 = F.b_router[r], b1 = F.b_router[16 + r];
#pragma unroll
            for (int i = 0; i < 4; ++i) { const float rs = __shfl(rstd, 4 * q + i); lg[(4 * q + i) * 36 + r] = a0[i] * rs + b0; lg[(4 * q + i) * 36 + 16 + r] = a1[i] * rs + b1; }
            LDS_WAIT(); asm volatile("" ::: "memory");
            if (lane < 16) {
                float v[32];
#pragma unroll
                for (int j = 0; j < 8; ++j) { const pg8::f32x4 t4 = *(const LAS pg8::f32x4*)(lg + lane * 36 + 4 * j); v[4 * j] = t4[0]; v[4 * j + 1] = t4[1]; v[4 * j + 2] = t4[2]; v[4 * j + 3] = t4[3]; }
                unsigned taken = 0u; float tv[4];
#pragma unroll
                for (int k = 0; k < 4; ++k) { float best = -3.0e38f; int bi = 0;
#pragma unroll
                    for (int e = 0; e < 32; ++e) { const bool c = !((taken >> e) & 1u) && (v[e] > best); best = c ? v[e] : best; bi = c ? e : bi; }
                    taken |= 1u << bi; pe[k] = bi; tv[k] = best; }
                const float e1 = __expf(tv[1] - tv[0]), e2 = __expf(tv[2] - tv[0]), e3 = __expf(tv[3] - tv[0]); const float inv = 1.f / (1.f + e1 + e2 + e3);
                pw[0] = inv; pw[1] = e1 * inv; pw[2] = e2 * inv; pw[3] = e3 * inv;
#pragma unroll
                for (int k = 0; k < 4; ++k) pl[k] = __hip_atomic_fetch_add(lcnt + pe[k], 1, __ATOMIC_RELAXED, __HIP_MEMORY_SCOPE_WORKGROUP);
            }
        }
        __syncthreads();
        if (F.tid < 32) lbase[F.tid] = (int)__hip_atomic_fetch_add(F.ctl + CW_CNT + 64 * F.tid, (unsigned)lcnt[F.tid], RLX_AGENT);
        __syncthreads();
        if (w < 4 && lane < 16) { const int tok = row0 + lane;
#pragma unroll
            for (int k = 0; k < 4; ++k) { const int e = pe[k], pos = lbase[e] + pl[k]; ltok[e * CAP + pos] = tok; lgate[e * CAP + pos] = pw[k]; lrstd[e * CAP + pos] = rstd; toke[tok * 4 + k] = e; tokp[tok * 4 + k] = pos; } }
    }
}
__device__ __forceinline__ void build_tables(Frame& F) {
    __syncthreads();
    if (F.tid < 32) F.TAB[F.tid] = (int)__hip_atomic_load(F.ctl + CW_CNT + 64 * F.tid, RLX_AGENT);
    __syncthreads();
    if (F.tid <= 32) { int acc = 0; for (int e = 0; e < F.tid; ++e) acc += (F.TAB[e] + 255) >> 8; F.TAB[32 + F.tid] = acc; }
    __syncthreads();
    if (F.tid < NRT_MAX && F.tid < F.TAB[64]) { int e = 0;
#pragma unroll 1
        for (int j = 1; j < 32; ++j) e = (F.TAB[32 + j] <= F.tid) ? j : e;
        while (e > 0 && F.TAB[32 + e] == F.TAB[32 + e + 1]) --e;
        F.TAB[72 + F.tid] = e; }
    __syncthreads();
}

__device__ __forceinline__ void p8_final(Frame& F) {
    const bf16* X1 = WSP(bf16, WS_X1); const unsigned char* Y = WSP(unsigned char, WS_Y); const int* toke = WSP(int, WS_TOKE); const int* tokp = WSP(int, WS_TOKP);
    int lane = F.lane; asm volatile("" : "+v"(lane));
    const int gw = F.vcu * NWAVES + F.wave, NGW = F.G * NWAVES;
    const GAS f32x4* gp = (const GAS f32x4*)F.final_g + lane; f32x4 g[4];
#pragma unroll
    for (int j = 0; j < 4; ++j) g[j] = gp[64 * j];
    for (int m = gw; m < T_TOK; m += NGW) {
        const GAS v2u* xr = (const GAS v2u*)(X1 + (size_t)m * DM) + lane; f32x4 v[4];
#pragma unroll
        for (int j = 0; j < 4; ++j) { const v2u xw = xr[64 * j]; v[j] = (f32x4){bf_lo(xw.x), bf_hi(xw.x), bf_lo(xw.y), bf_hi(xw.y)}; }
#pragma unroll
        for (int k = 0; k < 4; ++k) { const int e = toke[m * 4 + k], pos = tokp[m * 4 + k]; const size_t slot = (size_t)F.TAB[32 + e] * 256 + pos;
            const GAS unsigned* yr = (const GAS unsigned*)(Y + slot * 1024) + lane;
#pragma unroll
            for (int j = 0; j < 4; ++j) { const unsigned yv = yr[64 * j]; const f32x2_t lo = __builtin_amdgcn_cvt_pk_f32_fp8((int)yv, false), hi = __builtin_amdgcn_cvt_pk_f32_fp8((int)yv, true);
                v[j].x += lo[0]; v[j].y += lo[1]; v[j].z += hi[0]; v[j].w += hi[1]; } }
        float s2 = 0.f;
#pragma unroll
        for (int j = 0; j < 4; ++j) s2 += (v[j].x * v[j].x + v[j].y * v[j].y) + (v[j].z * v[j].z + v[j].w * v[j].w);
        const float rstd = 1.f / sqrtf(wave_sum(s2) * (1.f / DM) + RMS_EPS);
        GAS f32x4* o = (GAS f32x4*)(F.out + (size_t)m * DM) + lane;
#pragma unroll
        for (int j = 0; j < 4; ++j) o[64 * j] = v[j] * rstd * g[j];
    }
}

struct Args { const float* in[18]; float* out; unsigned char* ws; int ph_lo, ph_hi; };
__global__ void __launch_bounds__(NWAVES * 64, 2) mk_fwd(Args args) {
    extern __shared__ __attribute__((aligned(16))) unsigned char lds[];
    Frame F;
    F.lds = (LAS unsigned char*)lds;
    F.MISC = (volatile LAS unsigned*)(F.lds + MISC_OFF);
    F.TAB = (LAS int*)(F.lds + TAB_OFF);
    F.tid = threadIdx.x; F.lane = F.tid & 63; F.wave = __builtin_amdgcn_readfirstlane(F.tid >> 6);
    F.G = gridDim.x; F.bx = (int)blockIdx.x; F.xloc = 0; F.vcu = (F.G % 8 == 0) ? (F.bx % 8) * (F.G / 8) + F.bx / 8 : F.bx;
    F.ws = args.ws; F.ctl = (gu32*)(args.ws + WS_CTL); F.out = args.out;
    F.x = args.in[0]; F.norm1_g = args.in[1]; F.w_in = args.in[2]; F.pool_w = args.in[3]; F.pool_scale = args.in[4]; F.w_pool_proj = args.in[5]; F.sinks = args.in[6]; F.w_attn_proj = args.in[7];
    F.w_out = args.in[8]; F.norm2_g = args.in[9]; F.w_router = args.in[10]; F.b_router = args.in[11]; F.w_up = args.in[12]; F.b_up = args.in[13]; F.w_down = args.in[14]; F.b_down = args.in[15];
    F.rel_bias = args.in[16]; F.final_g = args.in[17];
    for (int u = F.tid; u < (LDS_BYTES - LDSCTL_OFF) / 4; u += NWAVES * 64) ((LAS unsigned*)(F.lds + LDSCTL_OFF))[u] = 0u;
    __syncthreads();
    XcdBarrier bar; bar.bar = (unsigned*)(F.ctl + CW_BAR); bar.x = 0; bar.st = nullptr;
    if (N_LAUNCHES == 1) bar = xcd_barrier_post((unsigned*)(F.ctl + CW_BAR), F.MISC + 8);
#define GRID_BAR() do { if (N_LAUNCHES == 1) xcd_barrier(bar); } while (0)
    const int lo = args.ph_lo, hi = args.ph_hi;
#ifndef PHASE_MASK
#define PHASE_MASK 0x1ff
#endif
#define IN(k) ((((PHASE_MASK) >> (k)) & 1) && lo <= (k) && (k) < hi)
    using pg8::StaticOrder;
#ifndef REP_MASK
#define REP_MASK 0
#endif
#define REP(k) (((REP_MASK) >> (k)) & 1)
#define PH0() do { p0_prologue(F); } while (0)
#define PH1() do { { ProbDense P{(const char*)WSP(bf16, WS_H1), (const char*)WSP(bf16, WS_WIN)}; EpiInProj E{WSP(bf16, WS_U), WSP(bf16, WS_Q), WSP(bf16, WS_KV), WSP(bf16, WS_GP), WSP(bf16, WS_GA)}; \
            if (F.G == 256) { P1Order S{F.bx & 7, F.bx >> 3, 0}; pg8::gemm_phase<ProbDense, EpiInProj, P1Order, true>(F.lds + RING_OFF, P, S, E); } \
            else { StaticOrder S; S.init(T_TOK / 256, 5, F.G, F.bx); pg8::gemm_phase<ProbDense, EpiInProj, StaticOrder, true>(F.lds + RING_OFF, P, S, E); } } \
        { ProbDense8 P{(const char*)WSP(unsigned char, WS_H18), (const char*)WSP(unsigned char, WS_WIN8)}; EpiGate8 E{WSP(unsigned char, WS_GP), WSP(unsigned char, WS_GA)}; \
            if (F.G == 256) { P1Order S{F.bx & 7, F.bx >> 3, 1}; pg8::gemm_phase<ProbDense8, EpiGate8, P1Order, true>(F.lds + RING_OFF, P, S, E); } \
            else { StaticOrder S; S.init(T_TOK / 256, 8, F.G, F.bx); pg8::gemm_phase<ProbDense8, EpiGate8, StaticOrder, true>(F.lds + RING_OFF, P, S, E); } } } while (0)
#ifndef CV_A
#define CV_A 3
#endif
#ifndef CV_B
#define CV_B 5
#endif
#define STG_RANK (((F.bx >> 4) << 3) + (F.bx & 7))
#define STG_PRE_W(W_, base, cvb) do { if (F.G == 256 && ((F.bx >> 3) & 1)) convert_moe_w<W_>(F, (base), (base) + 128 * (cvb), STG_RANK, 128); } while (0)
#define STG_POST_W(W_, base, cva, cvb) do { if (F.G == 256) { if (!((F.bx >> 3) & 1)) convert_moe_w<W_>(F, (base) + 128 * (cvb), (base) + 128 * ((cva) + (cvb)), STG_RANK, 128); } \
        else convert_moe_w<W_>(F, (base), (base) + 128 * ((cva) + (cvb)), F.vcu, F.G); } while (0)
#define STG_PRE(base, cvb) STG_PRE_W(1, base, cvb)
#define STG_POST(base, cva, cvb) STG_POST_W(1, base, cva, cvb)
#ifndef CV2_A
#define CV2_A 0
#endif
#ifndef CV2_B
#define CV2_B 0
#endif
#define CV_P2BASE (2 * 128 * (CV_A + CV_B))
#define CV_P5BASE (CV_P2BASE + 128 * (CV2_A + CV2_B))
#define PH2() do { if (F.xloc) STG_PRE_W(0, 0, 2); p2_attn_pool(F); if (F.xloc) STG_POST_W(0, 0, 1, 2); } while (0)
#define PH3() do { STG_PRE(0, CV_B); { ProbDense P{(const char*)WSP(bf16, WS_ZA), (const char*)WSP(bf16, WS_WMIX)}; StaticOrder S; S.init(T_TOK / 256, DM / 256, F.G, F.bx); \
        EpiMix E{WSP(unsigned char, WS_GP), WSP(unsigned char, WS_GA), WSP(bf16, WS_MIX)}; \
        pg8::gemm_phase<ProbDense, EpiMix, StaticOrder, true>(F.lds + RING_OFF, P, S, E); } STG_POST(0, CV_A, CV_B); } while (0)
#define PH4() do { STG_PRE(128 * (CV_A + CV_B), CV_B); { ProbDense P{(const char*)WSP(bf16, WS_MIX), (const char*)WSP(bf16, WS_WOUT)}; StaticOrder S; S.init(T_TOK / 256, DM / 256, F.G, F.bx); \
        EpiOut E{F.x, WSP(bf16, WS_X1)}; \
        pg8::gemm_phase<ProbDense, EpiOut, StaticOrder, true>(F.lds + RING_OFF, P, S, E); } STG_POST(128 * (CV_A + CV_B), CV_A, CV_B); } while (0)
#ifndef CV5_A
#define CV5_A 2
#endif
#ifndef CV5_B
#define CV5_B 3
#endif
#define DN_P1BASE (DN_SPLIT + 128 * (CV5_A + CV5_B))
#define PH5() do { STG_PRE_W(0, DN_SPLIT, CV5_B); p5_router(F); convert_moe_w<1>(F, CV_P5BASE, NEXP * 64, F.vcu, F.G); STG_POST_W(0, DN_SPLIT, CV5_A, CV5_B); } while (0)
#define PH6() do { ProbUp P{(const char*)WSP(bf16, WS_H2), (const char*)WSP(bf16, WS_WUP), WSP(int, WS_LTOK), F.TAB}; EpiUp E{F.b_up, WSP(float, WS_LRSTD), WSP(unsigned char, WS_ACT), F.TAB}; \
        const int nrt = __builtin_amdgcn_readfirstlane(F.TAB[64]); \
        if (F.xloc) { pg8::XccProducer S; S.init(nrt, 8, F.bx & 7, F.bx >> 3, 0); S.cnt = (unsigned*)(F.ctl + CW_RTC); pg8::gemm_phase<ProbUp, EpiUp, pg8::XccProducer, true>(F.lds + RING_OFF, P, S, E); } \
        else { StaticOrder S; S.init(nrt, 8, F.G, F.bx); pg8::gemm_phase<ProbUp, EpiUp, StaticOrder, true>(F.lds + RING_OFF, P, S, E); \
            { const int nwg = S.nwg, R = (nwg + F.G - 1) / F.G, nidle = R * F.G - nwg, c = F.bx; \
              if (nidle == 0) convert_moe_w<0>(F, 0, DN_SPLIT, c, F.G); else if (c >= F.G - nidle) convert_moe_w<0>(F, 0, DN_SPLIT, c - (F.G - nidle), nidle); } } } while (0)
#define PH7() do { ProbDown P{(const char*)WSP(bf16, WS_ACT), (const char*)WSP(bf16, WS_WDN), F.TAB}; EpiDown E{F.b_down, WSP(float, WS_LGATE), WSP(unsigned char, WS_Y), F.TAB}; \
        const int nrt = __builtin_amdgcn_readfirstlane(F.TAB[64]); \
        if (F.xloc) { pg8::XccConsumer S; { pg8::XccOrder U; U.init(nrt, 8, F.bx & 7, F.bx >> 3, 0); S.init(nrt, 4, F.bx & 7, F.bx >> 3, U.n); } S.cnt = (unsigned*)(F.ctl + CW_RTC); S.tmo = (unsigned*)(F.ctl + CW_TMO); \
            pg8::gemm_phase<ProbDown, EpiDown, pg8::XccConsumer, true>(F.lds + RING_OFF, P, S, E); } \
        else { StaticOrder S; S.init(nrt, 4, F.G, F.bx); pg8::gemm_phase<ProbDown, EpiDown, StaticOrder, true>(F.lds + RING_OFF, P, S, E); } } while (0)
#define PH8() do { p8_final(F); } while (0)
    if (IN(0)) { PH0(); GRID_BAR(); if (REP(0)) { PH0(); GRID_BAR(); } }
    if (N_LAUNCHES == 1 && lo == 0) {
        if (F.tid == 0) { int rank = 0, dense = 0; const int ok = xcc_layout(bar, rank, dense); F.MISC[12] = (unsigned)ok; F.MISC[13] = (unsigned)(rank * 8 + dense); }
        __syncthreads();
        if (F.MISC[12]) { F.xloc = 1; F.bx = (int)F.MISC[13]; F.vcu = (F.bx % 8) * (F.G / 8) + F.bx / 8; }
    }
#define LOCAL_BAR() do { if (N_LAUNCHES == 1) { if (F.xloc) xcc_barrier(bar); else xcd_barrier(bar); } } while (0)
    if (IN(1)) { PH1(); GRID_BAR(); if (REP(1)) { PH1(); GRID_BAR(); } }
    if (IN(2)) { PH2(); LOCAL_BAR(); if (REP(2)) { PH2(); LOCAL_BAR(); } }
    if (IN(3)) { PH3(); LOCAL_BAR(); if (REP(3)) { PH3(); LOCAL_BAR(); } }
    if (IN(4)) { PH4(); LOCAL_BAR(); if (REP(4)) { PH4(); LOCAL_BAR(); } }
    if (IN(5)) { PH5(); GRID_BAR(); if (REP(5)) { if (blockIdx.x == 0 && F.tid < 32) __hip_atomic_store(F.ctl + CW_CNT + 64 * F.tid, 0u, RLX_AGENT); GRID_BAR(); PH5(); GRID_BAR(); } }
    if (IN(6) || IN(7) || IN(8)) build_tables(F);
    if (IN(6)) { PH6(); if (!F.xloc) GRID_BAR(); if (REP(6)) { PH6(); GRID_BAR(); } }
    if (IN(7)) { PH7(); GRID_BAR(); if (REP(7)) { PH7(); GRID_BAR(); } }
    if (IN(8)) { PH8(); if (REP(8)) { GRID_BAR(); PH8(); } }
#undef IN
}

extern "C" void kernel_launch(void* const* d_in, const int* in_sizes, int n_in, void* d_out, int out_size, void* d_ws, size_t ws_size, hipStream_t stream) {
    static int grid = 0;
    if (grid == 0) {
        if (n_in != 18 || out_size != T_TOK * DM || ws_size < WS_END) { fprintf(stderr, "kernel_launch: unexpected problem (n_in %d out %d ws %zu)\n", n_in, out_size, ws_size); grid = -1; return; }
        int dev = 0, cus = 0, per_cu = 0;
        if (hipGetDevice(&dev) != hipSuccess || hipDeviceGetAttribute(&cus, hipDeviceAttributeMultiprocessorCount, dev) != hipSuccess) { grid = -1; return; }
        if (hipFuncSetAttribute((const void*)mk_fwd, hipFuncAttributeMaxDynamicSharedMemorySize, LDS_BYTES) != hipSuccess) { fprintf(stderr, "kernel_launch: hipFuncSetAttribute failed\n"); grid = -1; return; }
        if (hipOccupancyMaxActiveBlocksPerMultiprocessor(&per_cu, (const void*)mk_fwd, NWAVES * 64, LDS_BYTES) != hipSuccess || per_cu < 1) fprintf(stderr, "kernel_launch: occupancy query says %d\n", per_cu);
        (void)hipGetLastError();
        grid = cus;
    }
    if (grid < 0) return;
    if (hipMemsetAsync((char*)d_ws + WS_CTL, 0, CTL_ZERO_BYTES, stream) != hipSuccess) return;
    Args a{};
    for (int i = 0; i < 18; ++i) a.in[i] = (const float*)d_in[i];
    a.out = (float*)d_out; a.ws = (unsigned char*)d_ws;
    if (N_LAUNCHES == 1) { a.ph_lo = 0; a.ph_hi = PER_PHASE; hipLaunchKernelGGL(mk_fwd, dim3(grid), dim3(NWAVES * 64), LDS_BYTES, stream, a); }
    else { for (int p = 0; p < PER_PHASE; ++p) { a.ph_lo = p; a.ph_hi = p + 1; hipLaunchKernelGGL(mk_fwd, dim3(grid), dim3(NWAVES * 64), LDS_BYTES, stream, a); } }
}
```

```cpp
#include <hip/hip_runtime.h>
#include <cstdio>
#include <cstdint>

#ifndef MK_N_LAUNCHES
#define MK_N_LAUNCHES 1
#endif

constexpr int T_TOK = 16384, DM = 1024, SEQ = 4096, NB = 4;
constexpr int INW = 3328;
constexpr int NEXP = 32, TOPK = 4, DFF = 1024;
constexpr int CAP = 16384;
constexpr int NRT_MAX = 288;
constexpr int SLOT_ROWS = NRT_MAX * 256;
constexpr float RMS_EPS = 1e-5f;
constexpr float LOG2E = 1.4426950408889634f;

namespace pg8 {
#define PG8_LAS __attribute__((address_space(3)))
typedef unsigned short bf16_t;
typedef short bf16x8 __attribute__((ext_vector_type(8)));
typedef float f32x4 __attribute__((ext_vector_type(4)));
typedef float f32x2 __attribute__((ext_vector_type(2)));
typedef unsigned u32x4 __attribute__((ext_vector_type(4)));
typedef unsigned u32x2 __attribute__((ext_vector_type(2)));
constexpr int BM = 256, BK = 64, HALF = 128, HTB = HALF * BK * 2, STAGE_BYTES = 8 * HTB, NXCD = 8, WGM = 8;
constexpr int GK = 1024;

__host__ __device__ __forceinline__ int lds_byte(int r, int c) { const int st = (r >> 4) * 2 + (c >> 5), rr = r & 15, cc = c & 31, ob = rr * 64 + cc * 2; return st * 1024 + (ob ^ (((ob >> 9) & 1) << 5)); }
__host__ __device__ __forceinline__ void stage_rc(int b, int& R, int& C) { const int st = b / 1024, sb = b % 1024, swz = sb ^ (((sb >> 9) & 1) << 5); R = (st >> 1) * 16 + swz / 64; C = (st & 1) * 32 + (swz % 64) / 2; }
__host__ __device__ __forceinline__ int perm32(int rho) { const int n = rho >> 4, i = rho & 15; return 8 * (i >> 2) + 4 * n + (i & 3); }

struct Unit { int pm, pn; };
typedef int v4i_t __attribute__((ext_vector_type(4)));
typedef int v8i_t __attribute__((ext_vector_type(8)));
__device__ __forceinline__ v8i_t cat8(bf16x8 lo, bf16x8 hi) { return __builtin_shufflevector(__builtin_bit_cast(v4i_t, lo), __builtin_bit_cast(v4i_t, hi), 0, 1, 2, 3, 4, 5, 6, 7); }

struct StaticOrder {
    static constexpr bool WAITS = false, PUBLISHES = false;
    int nM, nN, nwg, G, c;
    __host__ __device__ void init(int nM_, int nN_, int G_, int c_) { nM = nM_; nN = nN_; nwg = nM * nN; G = G_; c = c_; }
    __host__ __device__ bool next(int i, Unit& u) const {
        const long L = (long)i * G + c; if (L >= nwg) return false;
        int wgid = (int)L; { const int q = nwg / NXCD, r = nwg % NXCD, xcd = wgid % NXCD, off = wgid / NXCD; wgid = (xcd < r ? xcd * (q + 1) : r * (q + 1) + (xcd - r) * q) + off; }
        const int nig = WGM * nN, gid = wgid / nig, fm = gid * WGM, gsz = (nM - fm) < WGM ? (nM - fm) : WGM;
        u.pm = fm + ((wgid % nig) % gsz); u.pn = (wgid % nig) / gsz; return true;
    }
};

__device__ __forceinline__ void glds16s(const char* sbase, unsigned voff, unsigned lds_dst) { unsigned keep;
    asm volatile("s_mov_b32 %0, m0\n\ts_mov_b32 m0, %3\n\ts_nop 2\n\tglobal_load_lds_dwordx4 %1, %2\n\ts_mov_b32 m0, %0" : "=&s"(keep) : "v"(voff), "s"(sbase), "s"(lds_dst) : "memory"); }
struct XccOrder {
    static constexpr bool WAITS = false, PUBLISHES = false;
    int r0, nr, nN, n, skip, r;
    __host__ __device__ void init(int nM, int nN_, int x, int r_, int skip_) { r0 = x * nM / NXCD; nr = (x + 1) * nM / NXCD - r0; nN = nN_; n = nr * nN; skip = skip_; r = r_; }
    __host__ __device__ int first_i() const { return skip <= r ? 0 : (skip - r + 31) / 32; }
    __host__ __device__ bool next(int i, Unit& u) const {
        const int k = (i + first_i()) * 32 + r - skip; if (k < 0 || k >= n) return false;
        constexpr int WG = 4; const int nig = WG * nN, gid = k / nig, fm = gid * WG, gsz = (nr - fm) < WG ? (nr - fm) : WG;
        u.pm = r0 + fm + ((k % nig) % gsz); u.pn = (k % nig) / gsz; return true;
    }
};
struct XccProducer : XccOrder {
    static constexpr bool WAITS = false, PUBLISHES = true;
    unsigned* cnt;
    __device__ __forceinline__ void publish(const Unit& u) const {
        if ((threadIdx.x & 63) == 0) __hip_atomic_fetch_add(cnt + 64 * u.pm, 1u, __ATOMIC_RELAXED, __HIP_MEMORY_SCOPE_AGENT); }
};
struct XccConsumer : XccOrder {
    static constexpr bool WAITS = true, PUBLISHES = false;
    unsigned* cnt; unsigned* tmo;
    __device__ __forceinline__ void a_ready(const Unit& u) const {
        if (threadIdx.x < 64) {
            unsigned sp = 0u;
            while ((unsigned)__builtin_amdgcn_readfirstlane(__hip_atomic_load(cnt + 64 * u.pm, __ATOMIC_RELAXED, __HIP_MEMORY_SCOPE_AGENT)) < 64u) {
                __builtin_amdgcn_s_sleep(2);
                if ((++sp & 255u) == 0u) { if (__builtin_amdgcn_readfirstlane(__hip_atomic_load(tmo, __ATOMIC_RELAXED, __HIP_MEMORY_SCOPE_AGENT)) != 0u) break;
                    if (sp > (1u << 20)) { if (threadIdx.x == 0) __hip_atomic_store(tmo, 1u, __ATOMIC_RELAXED, __HIP_MEMORY_SCOPE_AGENT); break; } } }
            __builtin_amdgcn_fence(__ATOMIC_ACQUIRE, "agent");
            asm volatile("s_waitcnt vmcnt(0)" ::: "memory");
        }
        asm volatile("" ::: "memory"); __builtin_amdgcn_s_barrier(); asm volatile("" ::: "memory");
    }
};
__device__ __forceinline__ unsigned cvt_pk_bf16(float lo, float hi) { unsigned r; asm volatile("v_cvt_pk_bf16_f32 %0, %1, %2" : "=v"(r) : "v"(lo), "v"(hi)); return r; }
__device__ __forceinline__ float bf_lo(unsigned w) { return __uint_as_float(w << 16); }
__device__ __forceinline__ float bf_hi(unsigned w) { return __uint_as_float(w & 0xffff0000u); }

template <class Prob, class Epi, class Sched, bool ALIGN_EPI>
__device__ __forceinline__ void gemm_phase(PG8_LAS unsigned char* lds, const Prob& P, const Sched& S, const Epi& E) {
    const int tid = threadIdx.x, wid = __builtin_amdgcn_readfirstlane(tid >> 6), lane = tid & 63, wr = wid >> 2, wc = wid & 3, fr = lane & 15, fq = lane >> 4;
    constexpr bool FP8 = Prob::FP8;
    constexpr int RB = FP8 ? GK : GK * 2;
    constexpr int nt = FP8 ? GK / 128 : GK / BK;
    unsigned voffA[2], voffB[2];
#pragma unroll
    for (int i = 0; i < 2; ++i) { int R, C; stage_rc(tid * 16 + i * 8192, R, C); const int Rb = Epi::PERM ? ((R & ~31) + perm32(R & 31)) : R;
        voffA[i] = (unsigned)(R * RB + C * 2); voffB[i] = (unsigned)(Rb * RB + C * 2); }
#define PG8_GATHER_LOAD(u, G_) do { int tid_ = tid; asm volatile("" : "+v"(tid_)); _Pragma("unroll") for (int i = 0; i < 2; ++i) { int R, C; stage_rc(tid_ * 16 + i * 8192, R, C); \
        G_[i] = P.a_rowoff(u, R); G_[2 + i] = P.a_rowoff(u, HALF + R); } } while (0)
#define PG8_GATHER_OFFS(G_, D0, D1) do { int tid_ = tid; asm volatile("" : "+v"(tid_)); _Pragma("unroll") for (int i = 0; i < 2; ++i) { int R, C; stage_rc(tid_ * 16 + i * 8192, R, C); \
        D0[i] = G_[i] * (unsigned)RB + (unsigned)(C * 2); D1[i] = G_[2 + i] * (unsigned)RB + (unsigned)(C * 2); } } while (0)
    constexpr size_t kstep = (size_t)(BK * 2);
    constexpr size_t hstep = (size_t)HALF * RB;
    const unsigned ldsw = (unsigned)wid * 1024u, lds0 = (unsigned)(uintptr_t)lds;
    const int aoff = lds_byte(wr * 64 + fr, fq * 8), boff = lds_byte(wc * 32 + fr, fq * 8);
#define PG8_SA(b, h) (((b) * 2 + (h)) * HTB)
#define PG8_SB(b, h) ((4 + (b) * 2 + (h)) * HTB)
#define PG8_STAGE(bufoff, gbase, voff) do { _Pragma("unroll") for (int _i = 0; _i < 2; ++_i) glds16s((const char*)(gbase), (voff)[_i], lds0 + (unsigned)(bufoff) + ldsw + (unsigned)(_i * 8192)); } while (0)
#define PG8_STAGE_A(b, h, gbase, VOG) do { if constexpr (Prob::GATHER) { PG8_STAGE(PG8_SA(b, h), (gbase), VOG); } else { PG8_STAGE(PG8_SA(b, h), (gbase) + (h) * hstep, voffA); } } while (0)
#define PG8_LDA(dst, b, h) do { _Pragma("unroll") for (int m = 0; m < 4; ++m) { if constexpr (FP8) { dst##8[m] = cat8(*(const PG8_LAS bf16x8*)(lds + PG8_SA(b, h) + aoff + m * 2048), *(const PG8_LAS bf16x8*)(lds + PG8_SA(b, h) + aoff + m * 2048 + 1024)); } \
        else { _Pragma("unroll") for (int k = 0; k < 2; ++k) dst[m][k] = *(const PG8_LAS bf16x8*)(lds + PG8_SA(b, h) + aoff + m * 2048 + k * 1024); } } } while (0)
#define PG8_LDB(dst, b, h) do { _Pragma("unroll") for (int n = 0; n < 2; ++n) { if constexpr (FP8) { dst##8[n] = cat8(*(const PG8_LAS bf16x8*)(lds + PG8_SB(b, h) + boff + n * 2048), *(const PG8_LAS bf16x8*)(lds + PG8_SB(b, h) + boff + n * 2048 + 1024)); } \
        else { _Pragma("unroll") for (int k = 0; k < 2; ++k) dst[n][k] = *(const PG8_LAS bf16x8*)(lds + PG8_SB(b, h) + boff + n * 2048 + k * 1024); } } } while (0)
#define PG8_MMA(ai, bj, At, Bt) do { __builtin_amdgcn_s_setprio(1); _Pragma("unroll") for (int m = 0; m < 4; ++m) _Pragma("unroll") for (int n = 0; n < 2; ++n) { \
        if constexpr (FP8) { asm volatile("v_mfma_f32_16x16x128_f8f6f4 %0, %1, %2, %0" : "+v"(acc[ai][bj][m][n]) : "v"(Bt##8[n]), "v"(At##8[m])); } \
        else { _Pragma("unroll") for (int k = 0; k < 2; ++k) acc[ai][bj][m][n] = __builtin_amdgcn_mfma_f32_16x16x32_bf16(Bt[n][k], At[m][k], acc[ai][bj][m][n], 0, 0, 0); } } \
        __builtin_amdgcn_s_setprio(0); } while (0)
#define PG8_WAIT_V(n) asm volatile("s_waitcnt vmcnt(" #n ")" ::: "memory")
#define PG8_WAIT_L(n) asm volatile("s_waitcnt lgkmcnt(" #n ")" ::: "memory")
#define PG8_BAR __builtin_amdgcn_s_barrier()
#define PG8_SCHED __builtin_amdgcn_sched_barrier(0)
    Unit cur, nxt; int ui = 0;
    if (!S.next(0, cur)) return;
    f32x4 acc[2][2][4][2];
#pragma unroll
    for (int a = 0; a < 2; ++a)
#pragma unroll
        for (int b = 0; b < 2; ++b)
#pragma unroll
            for (int m = 0; m < 4; ++m)
#pragma unroll
                for (int n = 0; n < 2; ++n) acc[a][b][m][n] = (f32x4){0.f, 0.f, 0.f, 0.f};
    bf16x8 At[4][2], B0[2][2], B1[2][2]; v8i_t At8[4], B08[2], B18[2]; typename Epi::Pre pre;
    const char* cA = P.a_tile(cur); const char* cB = P.b_tile(cur); Unit prv = cur;
    if constexpr (Sched::WAITS) S.a_ready(cur);
    unsigned vA0[2] = {0u, 0u}, vA1[2] = {0u, 0u}, vL1[2] = {0u, 0u};
    unsigned gix[4] = {0u, 0u, 0u, 0u};
    if constexpr (Prob::GATHER) { PG8_GATHER_LOAD(cur, gix); PG8_GATHER_OFFS(gix, vA0, vA1); vL1[0] = vA1[0]; vL1[1] = vA1[1]; }
    PG8_STAGE(PG8_SB(0, 0), cB, voffB); PG8_STAGE(PG8_SB(0, 1), cB + hstep, voffB); PG8_STAGE_A(0, 0, cA, vA0); PG8_STAGE_A(0, 1, cA, vA1);
    if (wr == 1) PG8_BAR;
    PG8_WAIT_V(2); PG8_BAR;
    PG8_STAGE(PG8_SB(1, 0), cB + kstep, voffB); PG8_STAGE_A(1, 0, cA + kstep, vA0); PG8_STAGE(PG8_SB(1, 1), cB + hstep + kstep, voffB);
    PG8_WAIT_V(6); PG8_BAR;
    for (;;) {
        const bool has_next = S.next(ui + 1, nxt);
        const char* nA = has_next ? P.a_tile(nxt) : cA; const char* nB = has_next ? P.b_tile(nxt) : cB;
        constexpr int NSEG = (Epi::MID > 0) ? 2 : 1;
#pragma unroll
        for (int seg = 0; seg < NSEG; ++seg) {
        if constexpr (Epi::MID > 0) { if (seg == 1) E.mid(acc, cur, wr, wc, fr, fq); }
        const int t_lo = (seg == 0) ? 0 : Epi::MID, t_hi = (Epi::MID > 0 && seg == 0) ? Epi::MID : nt;
#pragma unroll 1
        for (int t = t_lo; t < t_hi; t += 2) {
            const bool last = (t == nt - 2);
            const char* a1 = cA + (size_t)(t + 1) * kstep;
            const char* a2 = last ? nA : cA + (size_t)(t + 2) * kstep; const char* b2 = last ? nB : cB + (size_t)(t + 2) * kstep;
            const char* a3 = a2 + kstep; const char* b3 = b2 + kstep;
            if constexpr (Sched::WAITS) { if (last && has_next) S.a_ready(nxt); }
            if constexpr (Prob::GATHER) { if (has_next) { if (t == nt - 4) { PG8_GATHER_LOAD(nxt, gix); } if (last) { PG8_GATHER_OFFS(gix, vA0, vA1); } } }
            if constexpr (Epi::PREFETCH) { if (last) { int fr_ = fr, fq_ = fq; asm volatile("" : "+v"(fr_), "+v"(fq_)); E.prefetch(pre, cur, wr, wc, fr_, fq_); } }
            PG8_LDB(B0, 0, 0); PG8_LDB(B1, 0, 1); PG8_SCHED; PG8_LDA(At, 0, 0); PG8_STAGE_A(1, 1, a1, vL1);
            PG8_WAIT_V(8); PG8_WAIT_L(0); PG8_BAR; PG8_MMA(0, 0, At, B0); PG8_MMA(0, 1, At, B1); PG8_BAR; PG8_SCHED;
            PG8_LDA(At, 0, 1); PG8_STAGE(PG8_SB(0, 0), b2, voffB); PG8_STAGE(PG8_SB(0, 1), b2 + hstep, voffB); PG8_STAGE_A(0, 0, a2, vA0);
            PG8_WAIT_V(8); PG8_WAIT_L(0); PG8_BAR; PG8_MMA(1, 0, At, B0); PG8_MMA(1, 1, At, B1); PG8_BAR; PG8_SCHED;
            PG8_LDB(B0, 1, 0); PG8_LDB(B1, 1, 1); PG8_SCHED; PG8_LDA(At, 1, 0); PG8_STAGE_A(0, 1, a2, vA1);
            PG8_WAIT_V(8); PG8_WAIT_L(0); PG8_BAR; PG8_MMA(0, 0, At, B0); PG8_MMA(0, 1, At, B1); PG8_BAR; PG8_SCHED;
            PG8_LDA(At, 1, 1); PG8_STAGE(PG8_SB(1, 0), b3, voffB); PG8_STAGE(PG8_SB(1, 1), b3 + hstep, voffB); PG8_STAGE_A(1, 0, a3, vA0);
            PG8_WAIT_V(8); PG8_WAIT_L(0); PG8_BAR; PG8_MMA(1, 0, At, B0); PG8_MMA(1, 1, At, B1); PG8_BAR; PG8_SCHED;
        }
        }
        if constexpr (ALIGN_EPI) { if (wr == 0) PG8_BAR; }
        if constexpr (Sched::PUBLISHES) { if (ui > 0) { PG8_WAIT_V(0); S.publish(prv); } }
        if constexpr (FP8) asm volatile("s_nop 15\n\ts_nop 15" ::: "memory");
        { int fr_ = fr, fq_ = fq; asm volatile("" : "+v"(fr_), "+v"(fq_) :: "memory");
          E(acc, pre, cur, wr, wc, fr_, fq_); }
        if (!has_next) break;
#pragma unroll
        for (int a = 0; a < 2; ++a)
#pragma unroll
            for (int b = 0; b < 2; ++b)
#pragma unroll
                for (int m = 0; m < 4; ++m)
#pragma unroll
                    for (int n = 0; n < 2; ++n) acc[a][b][m][n] = (f32x4){0.f, 0.f, 0.f, 0.f};
        prv = cur; cur = nxt; cA = nA; cB = nB; ++ui;
        if constexpr (Prob::GATHER) { vL1[0] = vA1[0]; vL1[1] = vA1[1]; }
        if constexpr (ALIGN_EPI) { if (wr == 1) PG8_BAR; }
    }
    PG8_WAIT_V(0);
    if constexpr (Sched::PUBLISHES) S.publish(cur);
    if constexpr (!ALIGN_EPI) { if (wr == 0) PG8_BAR; }
    PG8_BAR;
#undef PG8_SA
#undef PG8_SB
#undef PG8_STAGE
#undef PG8_STAGE_A
#undef PG8_GATHER_OFFS
#undef PG8_GATHER_LOAD
#undef PG8_LDA
#undef PG8_LDB
#undef PG8_MMA
#undef PG8_WAIT_V
#undef PG8_WAIT_L
#undef PG8_BAR
#undef PG8_SCHED
}
}

constexpr int NWAVES = 8;
constexpr int N_LAUNCHES = MK_N_LAUNCHES;
constexpr int PER_PHASE = 9;

constexpr size_t MiB = 1u << 20;
constexpr size_t WS_CTL = 0, CTL_ZERO_BYTES = 1 * MiB;
constexpr size_t WS_WIN = 2 * MiB;
constexpr size_t WS_WMIX = 10 * MiB;
constexpr size_t WS_WOUT = 12 * MiB;
constexpr size_t WS_WRT = 14 * MiB;
constexpr size_t WS_WUP = 16 * MiB;
constexpr size_t WS_WDN = 144 * MiB;
constexpr size_t WS_H1 = 208 * MiB;
constexpr size_t WS_U = 240 * MiB;
constexpr size_t WS_Q = 256 * MiB;
constexpr size_t WS_KV = 272 * MiB;
constexpr size_t WS_GP = 280 * MiB;
constexpr size_t WS_GA = 312 * MiB;
constexpr size_t WS_ZA = 344 * MiB;
constexpr size_t WS_MIX = 376 * MiB;
constexpr size_t WS_X1 = 408 * MiB;
constexpr size_t WS_H2 = 472 * MiB;
constexpr size_t WS_LTOK = 504 * MiB;
constexpr size_t WS_LGATE = 506 * MiB;
constexpr size_t WS_LRSTD = 508 * MiB;
constexpr size_t WS_TOKE = 510 * MiB;
constexpr size_t WS_TOKP = 511 * MiB;
constexpr size_t WS_ACT = 512 * MiB;
constexpr size_t WS_Y = 656 * MiB;
constexpr size_t WS_H18 = 800 * MiB;
constexpr size_t WS_WIN8 = 816 * MiB;
constexpr size_t WS_END = 820 * MiB;
constexpr int CW_TMO = 0, CW_CODE = 1;
constexpr int CW_CNT = 1024;
constexpr int CW_BAR = 4096;
constexpr int CW_RTC = 32768;

constexpr int RING_OFF = 0, RING_BYTES = 131072;
constexpr int LDSCTL_OFF = RING_BYTES, MISC_OFF = LDSCTL_OFF + 320;
constexpr int TAB_OFF = MISC_OFF + 128;
constexpr int LDS_BYTES = 147456;
static_assert(TAB_OFF + (32 + 40 + NRT_MAX) * 4 <= LDS_BYTES, "LDS map");

#define GAS __attribute__((address_space(1)))
#define LAS __attribute__((address_space(3)))
typedef unsigned short bf16;
typedef unsigned v4u __attribute__((ext_vector_type(4)));
typedef unsigned v2u __attribute__((ext_vector_type(2)));
typedef float f32x4 __attribute__((ext_vector_type(4)));
typedef float f32x16 __attribute__((ext_vector_type(16)));
typedef short bf16x8 __attribute__((ext_vector_type(8)));
typedef GAS unsigned gu32;
#define RLX_AGENT __ATOMIC_RELAXED, __HIP_MEMORY_SCOPE_AGENT
#define LDS_WAIT() asm volatile("s_waitcnt lgkmcnt(0)" ::: "memory")
#define VM_WAIT() asm volatile("s_waitcnt vmcnt(0)" ::: "memory")
__device__ __forceinline__ unsigned f2bf(float f) { unsigned u = __builtin_bit_cast(unsigned, f); return (u + 0x7fffu + ((u >> 16) & 1u)) >> 16; }
__device__ __forceinline__ unsigned pk2(float lo, float hi) { return f2bf(lo) | (f2bf(hi) << 16); }
using pg8::cvt_pk_bf16; using pg8::bf_lo; using pg8::bf_hi;
typedef float f32x2_t __attribute__((ext_vector_type(2)));
typedef __bf16 bf16x2_t __attribute__((ext_vector_type(2)));
__device__ __forceinline__ unsigned cvtpk_s(float lo, float hi) { f32x2_t v = {lo, hi}; bf16x2_t b = __builtin_convertvector(v, bf16x2_t); return __builtin_bit_cast(unsigned, b); }

constexpr float W8_SCALE = 256.0f, W8_INV = 1.0f / 256.0f;
__device__ __forceinline__ float sat8(float x) { return __builtin_amdgcn_fmed3f(x, -448.f, 448.f); }
__device__ __forceinline__ unsigned pk4_fp8(float a, float b, float c, float d) { int w = 0; w = __builtin_amdgcn_cvt_pk_fp8_f32(sat8(a), sat8(b), w, false); w = __builtin_amdgcn_cvt_pk_fp8_f32(sat8(c), sat8(d), w, true); return (unsigned)w; }
#define XB_TMO      128
#define XB_XCNT(j)  (256  + 64 * (j))
#define XB_XSUB(j)  (1280 + 64 * (j))
#define XB_XGEN(j)  (2304 + 64 * (j))
#define XB_TOP      3328
#define XB_TOPGEN   3392
#define XCD_BAR_WORDS 3456
#define XB_LSUB(j)  (4096 + 64 * (j))
#define XB_LGEN(j)  (5120 + 64 * (j))
#define XB_SPIN_CAP (1u << 18)
__device__ __forceinline__ unsigned xb_ld(unsigned* p)              { return __hip_atomic_load(p, __ATOMIC_RELAXED, __HIP_MEMORY_SCOPE_AGENT); }
__device__ __forceinline__ unsigned xb_add(unsigned* p, unsigned v) { return __hip_atomic_fetch_add(p, v, __ATOMIC_RELAXED, __HIP_MEMORY_SCOPE_AGENT); }
__device__ __forceinline__ unsigned xb_xcc_id() { return (unsigned)__builtin_amdgcn_s_getreg((3 << 11) | 20) & 0xFu; }
#define XB_SPIN(cond, bar) do { unsigned _sp = 0; while (cond) { __builtin_amdgcn_s_sleep(1); \
    if ((++_sp & 255u) == 0u) { if (xb_ld(&(bar)[XB_TMO])) break; if (_sp > XB_SPIN_CAP) { atomicAdd(&(bar)[XB_TMO], 1u); break; } } } } while (0)
struct XcdBarrier { unsigned* bar; unsigned x; volatile LAS unsigned* st; };
__device__ __forceinline__ XcdBarrier xcd_barrier_post(unsigned* bar, volatile LAS unsigned* st) {
    XcdBarrier b; b.bar = bar; b.x = xb_xcc_id(); b.st = st;
    if (threadIdx.x == 0) st[2] = xb_add(&bar[XB_XCNT(b.x)], 1u);
    return b;
}
__device__ __forceinline__ void xcc_barrier(const XcdBarrier& b) {
    asm volatile("s_waitcnt vmcnt(0)" ::: "memory");
    __syncthreads();
    if (threadIdx.x == 0) {
        unsigned* bar = b.bar; const unsigned nloc = b.st[0];
        const unsigned old = xb_add(&bar[XB_LSUB(b.x)], 1u), gen = old / nloc;
        if (old + 1u == (gen + 1u) * nloc) xb_add(&bar[XB_LGEN(b.x)], 1u);
        else XB_SPIN(xb_ld(&bar[XB_LGEN(b.x)]) == gen, bar);
        __builtin_amdgcn_fence(__ATOMIC_ACQUIRE, "agent");
        asm volatile("s_waitcnt vmcnt(0)" ::: "memory");
    }
    __syncthreads();
}
__device__ __forceinline__ unsigned xcc_arrive(const XcdBarrier& b) {
    asm volatile("s_waitcnt vmcnt(0)" ::: "memory");
    __syncthreads();
    unsigned gen = 0u;
    if (threadIdx.x == 0) { unsigned* bar = b.bar; const unsigned nloc = b.st[0]; const unsigned old = xb_add(&bar[XB_LSUB(b.x)], 1u); gen = old / nloc;
        if (old + 1u == (gen + 1u) * nloc) xb_add(&bar[XB_LGEN(b.x)], 1u); }
    return gen;
}
__device__ __forceinline__ void xcc_wait(const XcdBarrier& b, unsigned gen) {
    if (threadIdx.x == 0) { unsigned* bar = b.bar;
        XB_SPIN(xb_ld(&bar[XB_LGEN(b.x)]) == gen, bar);
        __builtin_amdgcn_fence(__ATOMIC_ACQUIRE, "agent");
        asm volatile("s_waitcnt vmcnt(0)" ::: "memory"); }
    __syncthreads();
}
__device__ __forceinline__ int xcc_layout(const XcdBarrier& b, int& rank, int& dense) {
    unsigned* bar = b.bar; unsigned nx = 0u, lower = 0u; bool even = true; const unsigned mine = xb_ld(&bar[XB_XCNT(b.x)]);
#pragma unroll
    for (unsigned j = 0; j < 16; ++j) { const unsigned c = xb_ld(&bar[XB_XCNT(j)]); if (c) { ++nx; if (j < b.x) ++lower; if (c != mine) even = false; } }
    rank = (int)b.st[2]; dense = (int)lower;
    return (even && nx == 8u && mine == 32u && rank < 32) ? 1 : 0;
}
__device__ __forceinline__ void xcd_barrier_complete(unsigned* bar, unsigned x, unsigned& nloc, unsigned& nx) {
    const unsigned G = gridDim.x * gridDim.y * gridDim.z;
    unsigned sum, cnt, mine, sp = 0u;
    for (;;) {
        sum = 0u; cnt = 0u; mine = 0u;
#pragma unroll
        for (unsigned j = 0; j < 16; ++j) { const unsigned c = xb_ld(&bar[XB_XCNT(j)]); sum += c; cnt += (c > 0u) ? 1u : 0u; mine = (j == x) ? c : mine; }
        if (sum == G) break;
        __builtin_amdgcn_s_sleep(1);
        if ((++sp & 255u) == 0u) { if (xb_ld(&bar[XB_TMO])) break; if (sp > XB_SPIN_CAP) { atomicAdd(&bar[XB_TMO], 1u); break; } }
    }
    nloc = mine > 0u ? mine : 1u; nx = cnt > 0u ? cnt : 1u;
}
__device__ __forceinline__ void xcd_barrier(const XcdBarrier& b) {
    asm volatile("s_waitcnt vmcnt(0)" ::: "memory");
    __syncthreads();
    if (threadIdx.x == 0) {
        unsigned* bar = b.bar;
        __builtin_amdgcn_s_waitcnt(0);
        unsigned nloc = b.st[0], nx = b.st[1];
        if (nloc == 0u) { xcd_barrier_complete(bar, b.x, nloc, nx); b.st[0] = nloc; b.st[1] = nx; }
        const unsigned old = xb_add(&bar[XB_XSUB(b.x)], 1u);
        const unsigned gen = old / nloc;
        if (old + 1u == (gen + 1u) * nloc) {
            __builtin_amdgcn_fence(__ATOMIC_RELEASE, "agent");
            asm volatile("s_waitcnt vmcnt(0)" ::: "memory");
            const unsigned og = xb_add(&bar[XB_TOP], 1u);
            const unsigned tg = og / nx;
            if (og + 1u == (tg + 1u) * nx) xb_add(&bar[XB_TOPGEN], 1u);
            else XB_SPIN(xb_ld(&bar[XB_TOPGEN]) == tg, bar);
            __builtin_amdgcn_fence(__ATOMIC_ACQUIRE, "agent");
            xb_add(&bar[XB_XGEN(b.x)], 1u);
            asm volatile("s_waitcnt vmcnt(0)" ::: "memory");
        } else {
            XB_SPIN(xb_ld(&bar[XB_XGEN(b.x)]) == gen, bar);
            __builtin_amdgcn_fence(__ATOMIC_ACQUIRE, "agent");
            asm volatile("s_waitcnt vmcnt(0)" ::: "memory");
        }
    }
    __syncthreads();
}

struct Frame {
    LAS unsigned char* lds;
    volatile LAS unsigned* MISC;
    LAS int* TAB;
    gu32* ctl;
    int tid, lane, wave;
    int vcu, G, bx, xloc;
    const float *x, *norm1_g, *w_in, *pool_w, *pool_scale, *w_pool_proj, *sinks, *w_attn_proj, *w_out, *norm2_g, *w_router, *b_router, *w_up, *b_up, *w_down, *b_down, *rel_bias, *final_g;
    float* out;
    unsigned char* ws;
};
#define WSP(T_, off) ((T_*)(F.ws + (off)))

__device__ __forceinline__ float wave_sum(float v) {
#pragma unroll
    for (int o = 1; o < 64; o <<= 1) v += __shfl_xor(v, o);
    return v;
}

template <int MAP  >
__device__ __forceinline__ void p0_transpose_item(const float* W, int N, bf16* WT, int ldt, int koff, LAS float* scr, int item, int lane) {
    const int nblk = N / 32, kb = item / nblk, nb = item % nblk, k0 = 64 * kb, n0 = 32 * nb;
    float v[32];
#pragma unroll
    for (int i = 0; i < 32; ++i) { const int kk = 2 * i + (lane >> 5); v[i] = W[(size_t)(k0 + kk) * N + n0 + (lane & 31)]; }
#pragma unroll
    for (int i = 0; i < 32; ++i) { const int kk = 2 * i + (lane >> 5); scr[kk * 33 + (lane & 31)] = v[i]; }
    LDS_WAIT(); asm volatile("" ::: "memory");
    const int c = lane & 7;
#pragma unroll
    for (int j = 0; j < 4; ++j) { const int n = (lane >> 3) + 8 * j; const LAS float* s = scr + (8 * c) * 33 + n;
        v4u o; o.x = pk2(s[0 * 33], s[1 * 33]); o.y = pk2(s[2 * 33], s[3 * 33]); o.z = pk2(s[4 * 33], s[5 * 33]); o.w = pk2(s[6 * 33], s[7 * 33]);
        int nn = n0 + n;
        if (MAP == 1) { const int pn = nn >> 8, rem = nn & 255; nn = (pn << 8) + ((rem & 1) << 7) + (rem >> 1); }
        *(GAS v4u*)(WT + (size_t)nn * ldt + koff + k0 + 8 * c) = o; }
    LDS_WAIT(); asm volatile("" ::: "memory");
}
struct Fp8Src { const float* W; int N; unsigned char* WT; int item; const float* g; int ld; };
__device__ __forceinline__ void fp8_tile_load(Frame& F, const Fp8Src& S, f32x4 (&v)[16]) {
    const int nblk = S.N / 256, kb = S.item / nblk, nb = S.item % nblk;
    const float* src = S.W + (size_t)(128 * kb + 16 * F.wave) * S.ld + 256 * nb + 4 * F.lane;
#pragma unroll
    for (int i = 0; i < 16; ++i) v[i] = __builtin_nontemporal_load((const GAS f32x4*)(src + (size_t)i * S.ld));
}
__device__ __forceinline__ void fp8_tile_pack(Frame& F, const Fp8Src& S, const f32x4 (&v)[16], v4u (&o)[4]) {
    float sc[16]; const int kr = 128 * (S.item / (S.N / 256)) + 16 * F.wave;
#pragma unroll
    for (int i = 0; i < 16; ++i) sc[i] = S.g ? S.g[kr + i] * W8_SCALE : W8_SCALE;
#pragma unroll
    for (int j = 0; j < 4; ++j)
#pragma unroll
        for (int q = 0; q < 4; ++q) o[j][q] = pk4_fp8(v[4 * q][j] * sc[4 * q], v[4 * q + 1][j] * sc[4 * q + 1], v[4 * q + 2][j] * sc[4 * q + 2], v[4 * q + 3][j] * sc[4 * q + 3]);
}
template <int MAP>
__device__ __forceinline__ void fp8_tile_store(Frame& F, const Fp8Src& S, const v4u (&o)[4]) {
    const int nblk = S.N / 256, kb = S.item / nblk, nb = S.item % nblk, k0 = 128 * kb, n0 = 256 * nb, lane = F.lane, w = F.wave;
    LAS unsigned char* tile = F.lds + RING_OFF;
    __syncthreads();
#pragma unroll
    for (int j = 0; j < 4; ++j) { const int row = 4 * lane + j; *(LAS v4u*)(tile + row * 128 + ((w ^ (lane & 7)) << 4)) = o[j]; }
    __syncthreads();
#pragma unroll
    for (int i = 0; i < 4; ++i) { const int row = (F.tid >> 3) + 64 * i, c = F.tid & 7; const v4u t = *(const LAS v4u*)(tile + row * 128 + ((c ^ ((row >> 2) & 7)) << 4));
        int nn = n0 + row; if (MAP == 1) { const int pn = nn >> 8, rem = nn & 255; nn = (pn << 8) + ((rem & 1) << 7) + (rem >> 1); }
        *(GAS v4u*)(S.WT + (size_t)nn * 1024 + k0 + 16 * c) = t; }
}
template <int WHICH>
__device__ __forceinline__ void convert_moe_w(Frame& F, int lo, int hi, int first, int nblk) {
    constexpr int NW = WHICH ? 2048 : DM, I1 = (DM / 128) * (NW / 256);
    const float* Wsrc = WHICH ? F.w_up : F.w_down; unsigned char* Wdst = WHICH ? WSP(unsigned char, WS_WUP) : WSP(unsigned char, WS_WDN);
    f32x4 v[16]; int it = lo + first;
    Fp8Src cur{nullptr, NW, nullptr, 0, WHICH ? F.norm2_g : nullptr, NW};
    if (it < hi) { const int e = it / I1; cur.W = Wsrc + (size_t)e * DM * NW; cur.WT = Wdst + (size_t)e * NW * DM; cur.item = it % I1; fp8_tile_load(F, cur, v); }
    while (it < hi) {
        v4u o[4]; fp8_tile_pack(F, cur, v, o);
        const int nx = it + nblk; Fp8Src nxt = cur;
        if (nx < hi) { const int e = nx / I1; nxt.W = Wsrc + (size_t)e * DM * NW; nxt.WT = Wdst + (size_t)e * NW * DM; nxt.item = nx % I1; fp8_tile_load(F, nxt, v); }
        fp8_tile_store<WHICH>(F, cur, o);
        cur = nxt; it = nx;
    }
    __syncthreads();
}
#ifndef DN_SPLIT
#define DN_SPLIT 384
#endif
__device__ __forceinline__ void convert_win8(Frame& F) {
    f32x4 v[16];
    for (int it = F.vcu; it < 64; it += F.G) { Fp8Src S{F.w_in + 1280, 2048, WSP(unsigned char, WS_WIN8), it, nullptr, INW};
        fp8_tile_load(F, S, v); v4u o[4]; fp8_tile_pack(F, S, v, o); fp8_tile_store<0>(F, S, o); }
    __syncthreads();
}
__device__ __forceinline__ void p0_prologue(Frame& F) {
    LAS float* scr = (LAS float*)(F.lds + RING_OFF + F.wave * 16384);
    const int gw = F.vcu * NWAVES + F.wave, NGW = F.G * NWAVES, lane = F.lane;
    bf16* Win_t = WSP(bf16, WS_WIN); bf16* Wmix_t = WSP(bf16, WS_WMIX); bf16* Wout_t = WSP(bf16, WS_WOUT); bf16* Wrt = WSP(bf16, WS_WRT);
    unsigned char* Wup_t = WSP(unsigned char, WS_WUP); bf16* H1 = WSP(bf16, WS_H1);
    if (F.wave < 4) for (int it = F.vcu * 4 + F.wave; it < 16 * 64; it += F.G * 4) {
        const int nb = it & 15, k8 = it >> 4, n = nb * 64 + lane, k0 = k8 * 8, g = k0 >> 7, kk0 = k0 & 127;
        float a[8];
#pragma unroll
        for (int i = 0; i < 8; ++i) a[i] = 0.f;
        const float* pw = F.pool_w + ((size_t)g * 128 + kk0) * 128; const float* wp = F.w_pool_proj + (size_t)(g * 128) * DM + n; const float* ps = F.pool_scale + g * 128;
#pragma unroll 1
        for (int j0 = 0; j0 < 128; j0 += 16) {
            float b[16];
#pragma unroll
            for (int j = 0; j < 16; ++j) b[j] = wp[(size_t)(j0 + j) * DM];
#pragma unroll
            for (int j = 0; j < 16; ++j) { const float bs = b[j] * ps[j0 + j];
#pragma unroll
                for (int i = 0; i < 8; ++i) a[i] += pw[i * 128 + j0 + j] * bs; }
        }
        v4u o; o.x = pk2(a[0], a[1]); o.y = pk2(a[2], a[3]); o.z = pk2(a[4], a[5]); o.w = pk2(a[6], a[7]);
        *(GAS v4u*)(Wmix_t + (size_t)n * DM + k0) = o;
    }
    constexpr int I_IN = (DM / 64) * (INW / 32), I_OUT = (DM / 64) * (DM / 32), I_AP = (512 / 64) * (DM / 32);
    constexpr int NITEMS = I_IN + I_OUT + I_AP;
    for (int it = gw; it < NITEMS; it += NGW) {
        int r = it;
        if (r < I_IN) { p0_transpose_item<0>(F.w_in, INW, Win_t, DM, 0, scr, r, lane); continue; } r -= I_IN;
        if (r < I_OUT) { p0_transpose_item<0>(F.w_out, DM, Wout_t, DM, 0, scr, r, lane); continue; } r -= I_OUT;
        p0_transpose_item<0>(F.w_attn_proj, DM, Wmix_t, DM, 512, scr, r, lane);
    }
    {
        const GAS f32x4* gp = (const GAS f32x4*)F.norm1_g + lane; f32x4 g[4];
#pragma unroll
        for (int j = 0; j < 4; ++j) g[j] = gp[64 * j];
        for (int m = gw; m < T_TOK; m += NGW) {
            const GAS f32x4* xr = (const GAS f32x4*)(F.x + (size_t)m * DM) + lane; f32x4 v[4]; float s2 = 0.f;
#pragma unroll
            for (int j = 0; j < 4; ++j) { v[j] = __builtin_nontemporal_load(xr + 64 * j); s2 += (v[j].x * v[j].x + v[j].y * v[j].y) + (v[j].z * v[j].z + v[j].w * v[j].w); }
            const float rstd = 1.f / sqrtf(wave_sum(s2) * (1.f / DM) + RMS_EPS);
            GAS unsigned long long* o8 = (GAS unsigned long long*)(H1 + (size_t)m * DM) + lane; GAS unsigned* o4 = (GAS unsigned*)(WSP(unsigned char, WS_H18) + (size_t)m * DM) + lane;
#pragma unroll
            for (int j = 0; j < 4; ++j) { const float h0 = v[j].x * rstd * g[j].x, h1v = v[j].y * rstd * g[j].y, h2 = v[j].z * rstd * g[j].z, h3 = v[j].w * rstd * g[j].w;
                o8[64 * j] = (unsigned long long)pk2(h0, h1v) | ((unsigned long long)pk2(h2, h3) << 32); o4[64 * j] = pk4_fp8(h0, h1v, h2, h3); }
        }
    }
    convert_win8(F);
    for (int it = gw * 64 + lane; it < 32 * 128; it += NGW * 64) {
        const int e = it & 31, k0 = (it >> 5) * 8; unsigned hi[4], lo[4];
#pragma unroll
        for (int i = 0; i < 4; ++i) { const float v0 = F.w_router[(size_t)(k0 + 2 * i) * NEXP + e] * F.norm2_g[k0 + 2 * i], v1 = F.w_router[(size_t)(k0 + 2 * i + 1) * NEXP + e] * F.norm2_g[k0 + 2 * i + 1];
            hi[i] = pk2(v0, v1); lo[i] = pk2(v0 - bf_lo(hi[i]), v1 - bf_hi(hi[i])); }
        *(GAS v4u*)(Wrt + (size_t)e * DM + k0) = (v4u){hi[0], hi[1], hi[2], hi[3]};
        *(GAS v4u*)(Wrt + (size_t)(NEXP + e) * DM + k0) = (v4u){lo[0], lo[1], lo[2], lo[3]};
    }
}

struct ProbDense {
    static constexpr bool GATHER = false, FP8 = false;
    const char* A; const char* Bt;
    __device__ __forceinline__ const char* a_tile(const pg8::Unit& u) const { return A + (size_t)u.pm * (256 * 2048); }
    __device__ __forceinline__ const char* b_tile(const pg8::Unit& u) const { return Bt + (size_t)u.pn * (256 * 2048); }
    __device__ __forceinline__ unsigned a_rowoff(const pg8::Unit&, int) const { return 0u; }
};
struct ProbDense8 {
    static constexpr bool GATHER = false, FP8 = true;
    const char* A; const char* Bt;
    __device__ __forceinline__ const char* a_tile(const pg8::Unit& u) const { return A + (size_t)u.pm * (256 * 1024); }
    __device__ __forceinline__ const char* b_tile(const pg8::Unit& u) const { return Bt + (size_t)u.pn * (256 * 1024); }
    __device__ __forceinline__ unsigned a_rowoff(const pg8::Unit&, int) const { return 0u; }
};
struct P1Order {
    static constexpr bool WAITS = false, PUBLISHES = false;
    int x, r, fp8;
    __host__ __device__ bool next(int i, pg8::Unit& u) const {
        int j;
        if (!fp8) { if (i == 0) j = r; else if (i == 1 && r < 8) j = 32 + r; else return false; }
        else { if (r < 8) { if (i) return false; j = r; } else { j = r + 24 * i; if (i > 2 || j >= 64) return false; } }
        u.pm = 8 * x + (j & 7); u.pn = j >> 3; return true;
    }
};
struct ProbUp {
    static constexpr bool GATHER = true, FP8 = true;
    const char* A; const char* Bt; const int* ltok; const LAS int* TAB;
    __device__ __forceinline__ const char* a_tile(const pg8::Unit&) const { return A; }
    __device__ __forceinline__ const char* b_tile(const pg8::Unit& u) const { const int e = __builtin_amdgcn_readfirstlane(TAB[72 + u.pm]); return Bt + ((size_t)e * 2048 + (size_t)u.pn * 256) * 1024; }
    __device__ __forceinline__ unsigned a_rowoff(const pg8::Unit& u, int r) const {
        const int e = __builtin_amdgcn_readfirstlane(TAB[72 + u.pm]), pos = (u.pm - __builtin_amdgcn_readfirstlane(TAB[32 + e])) * 256 + r, cnt = __builtin_amdgcn_readfirstlane(TAB[e]);
        return (unsigned)ltok[e * CAP + (pos < cnt ? pos : 0)]; }
};
struct ProbDown {
    static constexpr bool GATHER = false, FP8 = true;
    const char* A; const char* Bt; const LAS int* TAB;
    __device__ __forceinline__ const char* a_tile(const pg8::Unit& u) const { return A + (size_t)u.pm * (256 * 1024); }
    __device__ __forceinline__ const char* b_tile(const pg8::Unit& u) const { const int e = __builtin_amdgcn_readfirstlane(TAB[72 + u.pm]); return Bt + ((size_t)e * 1024 + (size_t)u.pn * 256) * 1024; }
    __device__ __forceinline__ unsigned a_rowoff(const pg8::Unit&, int) const { return 0u; }
};

using pg8::f32x2; using pg8::u32x4;
struct NoPre {};
struct EpiInProj {
    static constexpr bool PERM = true, PREFETCH = false; static constexpr int MID = 0; typedef NoPre Pre;
    bf16 *U, *Q, *KV, *GP, *GA;
    __device__ __forceinline__ void mid(pg8::f32x4 (&)[2][2][4][2], const pg8::Unit&, int, int, int, int) const {}
    __device__ __forceinline__ void operator()(const pg8::f32x4 (&acc)[2][2][4][2], const NoPre&, const pg8::Unit& u, int wr, int wc, int fr, int fq) const {
        bf16* base; int ldc; float sc = 1.f; const int pn = u.pn;
        if (pn < 2) { base = U + pn * 256; ldc = 512; } else if (pn < 4) { base = Q + (pn - 2) * 256; ldc = 512; sc = 0.125f; } else if (pn == 4) { base = KV; ldc = 256; }
        else if (pn < 9) { base = GP + (pn - 5) * 256; ldc = 1024; } else { base = GA + (pn - 9) * 256; ldc = 1024; }
        const int row0 = u.pm * 256 + wr * 64 + fr, col0 = wc * 32 + 8 * fq;
#pragma unroll
        for (int ai = 0; ai < 2; ++ai)
#pragma unroll
            for (int m = 0; m < 4; ++m) { bf16* rowp = base + (size_t)(row0 + ai * 128 + m * 16) * ldc + col0;
#pragma unroll
                for (int bj = 0; bj < 2; ++bj) { const pg8::f32x4 v0 = acc[ai][bj][m][0] * sc, v1 = acc[ai][bj][m][1] * sc;
                    u32x4 w; w.x = cvt_pk_bf16(v0[0], v0[1]); w.y = cvt_pk_bf16(v0[2], v0[3]); w.z = cvt_pk_bf16(v1[0], v1[1]); w.w = cvt_pk_bf16(v1[2], v1[3]);
                    *(u32x4*)(rowp + bj * 128) = w; } }
    }
};
struct EpiGate8 {
    static constexpr bool PERM = true, PREFETCH = false; static constexpr int MID = 0; typedef NoPre Pre;
    unsigned char *GP, *GA;
    __device__ __forceinline__ void mid(pg8::f32x4 (&)[2][2][4][2], const pg8::Unit&, int, int, int, int) const {}
    __device__ __forceinline__ void operator()(const pg8::f32x4 (&acc)[2][2][4][2], const NoPre&, const pg8::Unit& u, int wr, int wc, int fr, int fq) const {
        unsigned char* base = (u.pn < 4) ? GP + u.pn * 256 : GA + (u.pn - 4) * 256;
        const int row0 = u.pm * 256 + wr * 64 + fr, col0 = wc * 32 + 8 * fq;
#pragma unroll
        for (int ai = 0; ai < 2; ++ai)
#pragma unroll
            for (int m = 0; m < 4; ++m) { unsigned char* rowp = base + (size_t)(row0 + ai * 128 + m * 16) * 1024 + col0;
#pragma unroll
                for (int bj = 0; bj < 2; ++bj) { const pg8::f32x4 v0 = acc[ai][bj][m][0] * W8_INV, v1 = acc[ai][bj][m][1] * W8_INV;
                    v2u w; w.x = pk4_fp8(v0[0], v0[1], v0[2], v0[3]); w.y = pk4_fp8(v1[0], v1[1], v1[2], v1[3]);
                    *(v2u*)(rowp + bj * 128) = w; } }
    }
};
__device__ __forceinline__ float clampf(float x, float lo, float hi) { return fminf(fmaxf(x, lo), hi); }
__device__ __forceinline__ float en(float x) { return __builtin_amdgcn_exp2f(-LOG2E * clampf(x, -80.f, 80.f)); }
struct EpiMix {
    static constexpr bool PERM = true, PREFETCH = false; static constexpr int MID = 8; typedef NoPre Pre;
    const unsigned char *GP, *GA; bf16* MIX;
    static __device__ __forceinline__ void dec8(v2u w, float (&x)[8]) {
        const f32x2_t a = __builtin_amdgcn_cvt_pk_f32_fp8((int)w.x, false), b = __builtin_amdgcn_cvt_pk_f32_fp8((int)w.x, true), c = __builtin_amdgcn_cvt_pk_f32_fp8((int)w.y, false), d = __builtin_amdgcn_cvt_pk_f32_fp8((int)w.y, true);
        x[0] = a[0]; x[1] = a[1]; x[2] = b[0]; x[3] = b[1]; x[4] = c[0]; x[5] = c[1]; x[6] = d[0]; x[7] = d[1]; }
    __device__ __forceinline__ void mid(pg8::f32x4 (&acc)[2][2][4][2], const pg8::Unit& u, int wr, int wc, int fr, int fq) const {
        const unsigned off0 = (unsigned)(u.pm * 256 + wr * 64 + fr) * 1024u + (unsigned)(u.pn * 256 + wc * 32 + 8 * fq);
#pragma unroll
        for (int ai = 0; ai < 2; ++ai) {
            v2u p[4][2], a[4][2];
#pragma unroll
            for (int m = 0; m < 4; ++m)
#pragma unroll
                for (int bj = 0; bj < 2; ++bj) { const unsigned off = off0 + (unsigned)((ai * 128 + m * 16) * 1024 + bj * 128); p[m][bj] = *(const v2u*)(GP + off); a[m][bj] = *(const v2u*)(GA + off); }
#pragma unroll
            for (int m = 0; m < 4; ++m)
#pragma unroll
                for (int bj = 0; bj < 2; ++bj) { float xp[8], xa[8]; dec8(p[m][bj], xp); dec8(a[m][bj], xa);
#pragma unroll
                    for (int c = 0; c < 8; ++c) acc[ai][bj][m][c >> 2][c & 3] *= (1.f + en(xa[c])) * __builtin_amdgcn_rcpf(1.f + en(xp[c]));
                    asm volatile("" : "+v"(acc[ai][bj][m][0]), "+v"(acc[ai][bj][m][1])); }
            asm volatile("" ::: "memory");
        }
    }
    __device__ __forceinline__ void operator()(const pg8::f32x4 (&acc)[2][2][4][2], const NoPre&, const pg8::Unit& u, int wr, int wc, int fr, int fq) const {
        const unsigned off0 = (unsigned)(u.pm * 256 + wr * 64 + fr) * 1024u + (unsigned)(u.pn * 256 + wc * 32 + 8 * fq);
        v2u a[2][4][2];
#pragma unroll
        for (int ai = 0; ai < 2; ++ai)
#pragma unroll
            for (int m = 0; m < 4; ++m)
#pragma unroll
                for (int bj = 0; bj < 2; ++bj) a[ai][m][bj] = *(const v2u*)(GA + off0 + (unsigned)((ai * 128 + m * 16) * 1024 + bj * 128));
#pragma unroll
        for (int ai = 0; ai < 2; ++ai)
#pragma unroll
            for (int m = 0; m < 4; ++m)
#pragma unroll
                for (int bj = 0; bj < 2; ++bj) { float xa[8], sg[8]; dec8(a[ai][m][bj], xa);
#pragma unroll
                    for (int c = 0; c < 8; ++c) sg[c] = __builtin_amdgcn_rcpf(1.f + en(xa[c]));
                    const pg8::f32x4 v0 = acc[ai][bj][m][0], v1 = acc[ai][bj][m][1];
                    u32x4 w; w.x = cvtpk_s(v0[0] * sg[0], v0[1] * sg[1]); w.y = cvtpk_s(v0[2] * sg[2], v0[3] * sg[3]); w.z = cvtpk_s(v1[0] * sg[4], v1[1] * sg[5]); w.w = cvtpk_s(v1[2] * sg[6], v1[3] * sg[7]);
                    *(u32x4*)(MIX + off0 + (unsigned)((ai * 128 + m * 16) * 1024 + bj * 128)) = w; }
    }
};
struct EpiOut {
    static constexpr bool PERM = true, PREFETCH = false; static constexpr int MID = 0; typedef NoPre Pre;
    const float* X; bf16* X1;
    __device__ __forceinline__ void mid(pg8::f32x4 (&)[2][2][4][2], const pg8::Unit&, int, int, int, int) const {}
    __device__ __forceinline__ void operator()(const pg8::f32x4 (&acc)[2][2][4][2], const NoPre&, const pg8::Unit& u, int wr, int wc, int fr, int fq) const {
        const unsigned off0 = (unsigned)(u.pm * 256 + wr * 64 + fr) * 1024u + (unsigned)(u.pn * 256 + wc * 32 + 8 * fq);
#pragma unroll
        for (int ai = 0; ai < 2; ++ai) {
            pg8::f32x4 xv[4][2][2];
#pragma unroll
            for (int m = 0; m < 4; ++m)
#pragma unroll
                for (int bj = 0; bj < 2; ++bj)
#pragma unroll
                    for (int n = 0; n < 2; ++n) xv[m][bj][n] = *(const pg8::f32x4*)(X + off0 + (unsigned)((ai * 128 + m * 16) * 1024 + bj * 128 + n * 4));
#pragma unroll
            for (int m = 0; m < 4; ++m)
#pragma unroll
                for (int bj = 0; bj < 2; ++bj) { const pg8::f32x4 v0 = xv[m][bj][0] + acc[ai][bj][m][0], v1 = xv[m][bj][1] + acc[ai][bj][m][1];
                    u32x4 w; w.x = cvtpk_s(v0[0], v0[1]); w.y = cvtpk_s(v0[2], v0[3]); w.z = cvtpk_s(v1[0], v1[1]); w.w = cvtpk_s(v1[2], v1[3]);
                    *(u32x4*)(X1 + off0 + (unsigned)((ai * 128 + m * 16) * 1024 + bj * 128)) = w; }
            asm volatile("" ::: "memory");
        }
    }
};
struct EpiUp {
    static constexpr bool PERM = true, PREFETCH = true; static constexpr int MID = 0;
    struct Pre { pg8::f32x4 bq[4]; float rsv[2][4]; };
    const float* b_up; const float* lrstd; unsigned char* ACT; const LAS int* TAB;
    __device__ __forceinline__ void prefetch(Pre& p, const pg8::Unit& u, int wr, int wc, int fr, int fq) const {
        const int e = __builtin_amdgcn_readfirstlane(TAB[72 + u.pm]), pos0 = (u.pm - __builtin_amdgcn_readfirstlane(TAB[32 + e])) * 256, cnt = __builtin_amdgcn_readfirstlane(TAB[e]);
        const int rl0 = wr * 64 + fr, cc0 = wc * 32 + 8 * fq;
        const float* bp = b_up + (size_t)e * 2048 + 2 * (128 * u.pn + cc0);
#pragma unroll
        for (int q = 0; q < 4; ++q) p.bq[q] = *(const pg8::f32x4*)(bp + 4 * q);
#pragma unroll
        for (int ai = 0; ai < 2; ++ai)
#pragma unroll
            for (int m = 0; m < 4; ++m) { const int pos = pos0 + rl0 + ai * 128 + m * 16; p.rsv[ai][m] = lrstd[e * CAP + (pos < cnt ? pos : 0)]; }
    }
    __device__ __forceinline__ void mid(pg8::f32x4 (&)[2][2][4][2], const pg8::Unit&, int, int, int, int) const {}
    __device__ __forceinline__ void operator()(const pg8::f32x4 (&acc)[2][2][4][2], const Pre& pre, const pg8::Unit& u, int wr, int wc, int fr, int fq) const {
        const int e = __builtin_amdgcn_readfirstlane(TAB[72 + u.pm]), pos0 = (u.pm - __builtin_amdgcn_readfirstlane(TAB[32 + e])) * 256, cnt = __builtin_amdgcn_readfirstlane(TAB[e]);
        const int rl0 = wr * 64 + fr, cc0 = wc * 32 + 8 * fq;
        const pg8::f32x4 (&bq)[4] = pre.bq; float rsv[2][4];
#pragma unroll
        for (int ai = 0; ai < 2; ++ai)
#pragma unroll
            for (int m = 0; m < 4; ++m) rsv[ai][m] = (pos0 + rl0 + ai * 128 + m * 16) < cnt ? pre.rsv[ai][m] * W8_INV : 0.f;
        f32x2 bg[4], bl[4];
#pragma unroll
        for (int q = 0; q < 4; ++q) { bg[q] = (f32x2){bq[q][0], bq[q][2]}; bl[q] = (f32x2){bq[q][1], bq[q][3]}; }
        constexpr float KS = -1.702f * LOG2E;
#pragma unroll
        for (int ai = 0; ai < 2; ++ai)
#pragma unroll
            for (int m = 0; m < 4; ++m) { const int rl = rl0 + ai * 128 + m * 16; const float rs = rsv[ai][m]; const f32x2 rs2 = (f32x2){rs, rs};
                unsigned pk[4];
#pragma unroll
                for (int p = 0; p < 4; ++p) { const int n = p >> 1, i = (p & 1) * 2;
                    f32x2 g = (f32x2){acc[ai][0][m][n][i], acc[ai][0][m][n][i + 1]} * rs2 + bg[p], l = (f32x2){acc[ai][1][m][n][i], acc[ai][1][m][n][i + 1]} * rs2 + bl[p];
                    g.x = fminf(g.x, 7.0f); g.y = fminf(g.y, 7.0f); l.x = __builtin_amdgcn_fmed3f(l.x, -7.0f, 7.0f); l.y = __builtin_amdgcn_fmed3f(l.y, -7.0f, 7.0f);
                    const f32x2 t = g * KS; f32x2 ex; ex.x = __builtin_amdgcn_exp2f(t.x); ex.y = __builtin_amdgcn_exp2f(t.y);
                    const f32x2 d = ex + 1.0f; f32x2 sg; sg.x = __builtin_amdgcn_rcpf(d.x); sg.y = __builtin_amdgcn_rcpf(d.y);
                    const f32x2 o = g * sg, r = o * l + o;
                    pk[p] = (unsigned)__builtin_amdgcn_cvt_pk_fp8_f32(r.x, r.y, 0, false) & 0xffffu; }
                v2u w; w.x = pk[0] | (pk[1] << 16); w.y = pk[2] | (pk[3] << 16);
                *(v2u*)(ACT + (size_t)(u.pm * 256 + rl) * 1024 + 128 * u.pn + cc0) = w; }
    }
};
struct EpiDown {
    static constexpr bool PERM = true, PREFETCH = true; static constexpr int MID = 0;
    struct Pre { pg8::f32x4 bv[2][2]; float gtv[2][4]; };
    const float* b_dn; const float* lgate; unsigned char* Y; const LAS int* TAB;
    __device__ __forceinline__ void prefetch(Pre& p, const pg8::Unit& u, int wr, int wc, int fr, int fq) const {
        const int e = __builtin_amdgcn_readfirstlane(TAB[72 + u.pm]), pos0 = (u.pm - __builtin_amdgcn_readfirstlane(TAB[32 + e])) * 256, cnt = __builtin_amdgcn_readfirstlane(TAB[e]);
        const int rl0 = wr * 64 + fr, col0 = u.pn * 256 + wc * 32 + 8 * fq;
#pragma unroll
        for (int bj = 0; bj < 2; ++bj)
#pragma unroll
            for (int n = 0; n < 2; ++n) p.bv[bj][n] = *(const pg8::f32x4*)(b_dn + (size_t)e * 1024 + col0 + bj * 128 + 4 * n);
#pragma unroll
        for (int ai = 0; ai < 2; ++ai)
#pragma unroll
            for (int m = 0; m < 4; ++m) { const int pos = pos0 + rl0 + ai * 128 + m * 16; p.gtv[ai][m] = lgate[e * CAP + (pos < cnt ? pos : 0)]; }
    }
    __device__ __forceinline__ void mid(pg8::f32x4 (&)[2][2][4][2], const pg8::Unit&, int, int, int, int) const {}
    __device__ __forceinline__ void operator()(const pg8::f32x4 (&acc)[2][2][4][2], const Pre& pre, const pg8::Unit& u, int wr, int wc, int fr, int fq) const {
        const int e = __builtin_amdgcn_readfirstlane(TAB[72 + u.pm]), pos0 = (u.pm - __builtin_amdgcn_readfirstlane(TAB[32 + e])) * 256, cnt = __builtin_amdgcn_readfirstlane(TAB[e]);
        const int rl0 = wr * 64 + fr, col0 = u.pn * 256 + wc * 32 + 8 * fq;
        const pg8::f32x4 (&bv)[2][2] = pre.bv; float gtv[2][4];
#pragma unroll
        for (int ai = 0; ai < 2; ++ai)
#pragma unroll
            for (int m = 0; m < 4; ++m) gtv[ai][m] = (pos0 + rl0 + ai * 128 + m * 16) < cnt ? pre.gtv[ai][m] : 0.f;
#pragma unroll
        for (int ai = 0; ai < 2; ++ai)
#pragma unroll
            for (int m = 0; m < 4; ++m) { const int rl = rl0 + ai * 128 + m * 16; const float gt = gtv[ai][m], gs = gt * W8_INV;
                unsigned char* rowp = Y + (size_t)(u.pm * 256 + rl) * 1024 + col0;
#pragma unroll
                for (int bj = 0; bj < 2; ++bj) { const pg8::f32x4 v0 = acc[ai][bj][m][0] * gs + bv[bj][0] * gt, v1 = acc[ai][bj][m][1] * gs + bv[bj][1] * gt;
                    v2u w; w.x = pk4_fp8(v0[0], v0[1], v0[2], v0[3]); w.y = pk4_fp8(v1[0], v1[1], v1[2], v1[3]);
                    *(v2u*)(rowp + bj * 128) = w; } }
    }
};

__device__ const unsigned char T5_BUCKET[128] = {0, 1, 2, 3, 4, 5, 6, 7, 8, 9, 10, 11, 12, 13, 14, 15, 16, 16, 16, 17, 17, 18, 18, 18, 19, 19, 19, 20, 20, 20, 20, 21, 21, 21, 21, 22, 22, 22, 22, 22, 23, 23, 23, 23, 23, 23, 24, 24, 24, 24, 24, 24, 25, 25, 25, 25, 25, 25, 25, 26, 26, 26, 26, 26, 26, 26, 26, 27, 27, 27, 27, 27, 27, 27, 27, 27, 27, 28, 28, 28, 28, 28, 28, 28, 28, 28, 28, 29, 29, 29, 29, 29, 29, 29, 29, 29, 29, 29, 29, 30, 30, 30, 30, 30, 30, 30, 30, 30, 30, 30, 30, 30, 30, 31, 31, 31, 31, 31, 31, 31, 31, 31, 31, 31, 31, 31, 31, 31};
constexpr int KS_PITCH = 144, VT_PITCH = 520;
constexpr int ATT_KS = 0, ATT_VT = 256 * KS_PITCH, ATT_BIAS = ATT_VT + 64 * VT_PITCH;
static_assert(ATT_BIAS + 4 * 128 * 4 <= RING_BYTES, "attention LDS");
__device__ __forceinline__ int crow(int i, int hi) { return (i & 3) + 8 * (i >> 2) + 4 * hi; }
__device__ __forceinline__ void attn_unit(Frame& F, int b, int nblk, int kvh) {
    const bf16* Q = WSP(bf16, WS_Q); const bf16* KV = WSP(bf16, WS_KV); bf16* ZA = WSP(bf16, WS_ZA);
    LAS unsigned char* ks = F.lds + RING_OFF + ATT_KS; LAS unsigned char* vt = F.lds + RING_OFF + ATT_VT; LAS float* bias2 = (LAS float*)(F.lds + RING_OFF + ATT_BIAS);
    const int tid = F.tid, lane = F.lane, w = F.wave;
    const int kpos0 = (nblk - 1) * 128;
    bf16x8 qfa[2][4];
    { const int g_ = w >> 1, qh_ = kvh * 4 + g_, ql_ = lane & 31, hi_ = lane >> 5;
#pragma unroll
      for (int qt2 = 0; qt2 < 2; ++qt2) { const size_t tq_ = (size_t)b * SEQ + nblk * 128 + 32 * (2 * (w & 1) + qt2) + ql_;
#pragma unroll
          for (int s2 = 0; s2 < 4; ++s2) qfa[qt2][s2] = *(const GAS bf16x8*)(Q + tq_ * 512 + qh_ * 64 + s2 * 16 + hi_ * 8); } }
    __syncthreads();
#pragma unroll
    for (int i = 0; i < 4; ++i) {
        const int c = tid + 512 * i, row = c >> 3, part = c & 7; const int kp = kpos0 + row;
        v4u kk = (v4u){0u, 0u, 0u, 0u}, vv = (v4u){0u, 0u, 0u, 0u};
        if (kp >= 0) { const bf16* src = KV + (size_t)(b * SEQ + kp) * 256 + kvh * 64 + part * 8; kk = *(const GAS v4u*)src; vv = *(const GAS v4u*)(src + 128); }
        *(LAS v4u*)(ks + row * KS_PITCH + part * 16) = kk;
        LAS unsigned short* vd = (LAS unsigned short*)(vt + (part * 8) * VT_PITCH + row * 2);
#pragma unroll
        for (int j = 0; j < 4; ++j) { vd[(2 * j) * (VT_PITCH / 2)] = (unsigned short)(vv[j] & 0xffffu); vd[(2 * j + 1) * (VT_PITCH / 2)] = (unsigned short)(vv[j] >> 16); }
    }
    { const int g = tid >> 7, d = tid & 127; bias2[tid] = F.rel_bias[(int)T5_BUCKET[d] * 8 + kvh * 4 + g] * LOG2E; }
    __syncthreads();
    const int g = w >> 1, qh = kvh * 4 + g, ql = lane & 31, hi = lane >> 5;
    const float sink2 = F.sinks[qh] * LOG2E;
#pragma unroll 1
    for (int qt2 = 0; qt2 < 2; ++qt2) {
        const int q0 = 32 * (2 * (w & 1) + qt2), qi = q0 + ql; const size_t tq = (size_t)b * SEQ + nblk * 128 + qi;
        bf16x8 qf[4];
#pragma unroll
        for (int s = 0; s < 4; ++s) qf[s] = qt2 ? qfa[1][s] : qfa[0][s];
        f32x16 sc[5];
#pragma unroll
        for (int kt = 0; kt < 5; ++kt) {
            f32x16 a;
#pragma unroll
            for (int i = 0; i < 16; ++i) a[i] = 0.f;
            const int kb = q0 + 32 * kt;
#pragma unroll
            for (int s = 0; s < 4; ++s) { const bf16x8 kf = *(const LAS bf16x8*)(ks + (kb + ql) * KS_PITCH + s * 32 + hi * 16); a = __builtin_amdgcn_mfma_f32_32x32x16_bf16(kf, qf[s], a, 0, 0, 0); }
            sc[kt] = a;
        }
        float mx = sink2;
#pragma unroll
        for (int kt = 0; kt < 5; ++kt)
#pragma unroll
            for (int i = 0; i < 16; ++i) { const int kj = q0 + 32 * kt + crow(i, hi), dist = 128 + qi - kj; const bool ok = (dist >= 0) && (dist < 128) && (kpos0 + kj >= 0);
                const float s = ok ? sc[kt][i] * LOG2E + bias2[g * 128 + (dist & 127)] : -1e30f; sc[kt][i] = s; mx = fmaxf(mx, s); }
        mx = fmaxf(mx, __shfl_xor(mx, 32));
        float l = 0.f;
#pragma unroll
        for (int kt = 0; kt < 5; ++kt)
#pragma unroll
            for (int i = 0; i < 16; ++i) { const float p = __builtin_amdgcn_exp2f(sc[kt][i] - mx); sc[kt][i] = p; l += p; }
        l += __shfl_xor(l, 32); l += __builtin_amdgcn_exp2f(sink2 - mx);
        const float inv = 1.f / l;
        f32x16 o[2];
#pragma unroll
        for (int dt = 0; dt < 2; ++dt)
#pragma unroll
            for (int i = 0; i < 16; ++i) o[dt][i] = 0.f;
#pragma unroll
        for (int kt = 0; kt < 5; ++kt)
#pragma unroll
            for (int ss = 0; ss < 2; ++ss) {
                v4u pw;
#pragma unroll
                for (int j = 0; j < 4; ++j) pw[j] = cvt_pk_bf16(sc[kt][8 * ss + 2 * j], sc[kt][8 * ss + 2 * j + 1]);
                const bf16x8 pf = __builtin_bit_cast(bf16x8, pw);
                const int kv0 = q0 + 32 * kt + 16 * ss + 4 * hi;
#pragma unroll
                for (int dt = 0; dt < 2; ++dt) { const LAS unsigned char* vp = vt + (dt * 32 + ql) * VT_PITCH + kv0 * 2;
                    const v2u v0 = *(const LAS v2u*)vp, v1 = *(const LAS v2u*)(vp + 16); const v4u vw = (v4u){v0.x, v0.y, v1.x, v1.y};
                    o[dt] = __builtin_amdgcn_mfma_f32_32x32x16_bf16(__builtin_bit_cast(bf16x8, vw), pf, o[dt], 0, 0, 0); }
            }
        bf16* orow = ZA + tq * 1024 + 512 + qh * 64;
#pragma unroll
        for (int dt = 0; dt < 2; ++dt)
#pragma unroll
            for (int q4 = 0; q4 < 4; ++q4) { v2u ww; ww.x = cvt_pk_bf16(o[dt][4 * q4] * inv, o[dt][4 * q4 + 1] * inv); ww.y = cvt_pk_bf16(o[dt][4 * q4 + 2] * inv, o[dt][4 * q4 + 3] * inv);
                *(GAS v2u*)(orow + dt * 32 + 8 * q4 + 4 * hi) = ww; }
    }
}
__device__ __forceinline__ void p2_attn_pool(Frame& F) {
    for (int uidx = F.vcu; uidx < NB * 32 * 2; uidx += F.G) { const int kvh = uidx & 1, nblk = (uidx >> 1) & 31, b = uidx >> 6; attn_unit(F, b, nblk, kvh); }
    const bf16* U = WSP(bf16, WS_U); bf16* ZA = WSP(bf16, WS_ZA);
    for (int it = F.vcu * NWAVES + F.wave; it < T_TOK / 8; it += F.G * NWAVES) {
        const int t0 = it * 8, c8 = F.lane, g = c8 >> 4, wnd = 2 << g, pos0 = t0 & (SEQ - 1);
        const bf16* up = U + (size_t)t0 * 512 + c8 * 8;
        v4u ur[23];
#pragma unroll
        for (int j = 0; j < 23; ++j) { const int rel = j - 15; ur[j] = (v4u){0u, 0u, 0u, 0u}; if (rel > -wnd && pos0 + rel >= 0) ur[j] = *(const GAS v4u*)(up + (ptrdiff_t)rel * 512); }
#pragma unroll
        for (int i = 0; i < 8; ++i) {
            const int pos = pos0 + i, cnt = (pos + 1) < wnd ? (pos + 1) : wnd;
            float sacc[8];
#pragma unroll
            for (int q = 0; q < 4; ++q) { sacc[2 * q] = bf_lo(ur[15 + i][q]); sacc[2 * q + 1] = bf_hi(ur[15 + i][q]); }
#pragma unroll
            for (int j = 1; j < 16; ++j) { const bool on = j < cnt;
#pragma unroll
                for (int q = 0; q < 4; ++q) { const unsigned wv = ur[15 + i - j][q]; sacc[2 * q] += on ? bf_lo(wv) : 0.f; sacc[2 * q + 1] += on ? bf_hi(wv) : 0.f; } }
            const float ic = 1.0f / (float)cnt; v4u o;
#pragma unroll
            for (int q = 0; q < 4; ++q) o[q] = cvtpk_s(sacc[2 * q] * ic - bf_lo(ur[15 + i][q]), sacc[2 * q + 1] * ic - bf_hi(ur[15 + i][q]));
            *(GAS v4u*)(ZA + (size_t)(t0 + i) * 1024 + c8 * 8) = o;
        }
    }
}

constexpr int P5_OFF = 133120;
static_assert(P5_OFF >= TAB_OFF + (32 + 40 + NRT_MAX) * 4 && P5_OFF + 4 * 2304 + 256 <= LDS_BYTES, "router scratch");
__device__ __forceinline__ void p5_router(Frame& F) {
    const bf16* X1 = WSP(bf16, WS_X1); unsigned char* H2 = WSP(unsigned char, WS_H2); const char* Wg = (const char*)WSP(bf16, WS_WRT);
    int* ltok = WSP(int, WS_LTOK); float* lgate = WSP(float, WS_LGATE); float* lrstd = WSP(float, WS_LRSTD); int* toke = WSP(int, WS_TOKE); int* tokp = WSP(int, WS_TOKP);
    int lane = F.lane; asm volatile("" : "+v"(lane));
    const int w = F.wave, r = lane & 15, q = lane >> 4, rg = w;
    LAS float* lg = (LAS float*)(F.lds + P5_OFF + (rg & 3) * 2304);
    LAS int* lcnt = (LAS int*)(F.lds + P5_OFF + 4 * 2304); LAS int* lbase = lcnt + 32;
    const LAS unsigned char* wl = F.lds + RING_OFF;
    const unsigned lds0 = (unsigned)(uintptr_t)(F.lds + RING_OFF);
    for (int tb = F.vcu; tb < T_TOK / 64; tb += F.G) {
        __syncthreads();
        if (F.tid < 32) lcnt[F.tid] = 0;
        int pe[4] = {0, 0, 0, 0}, pl[4] = {0, 0, 0, 0}; float pw[4] = {0.f, 0.f, 0.f, 0.f}; float rstd = 0.f;
        const int row0 = tb * 64 + (rg & 3) * 16;
        bf16x8 xr[32];
        if (w < 4) { const bf16* xp = X1 + (size_t)(row0 + r) * 1024 + 8 * q;
#pragma unroll
            for (int s2 = 0; s2 < 32; ++s2) xr[s2] = *(const GAS bf16x8*)(xp + 32 * s2); }
#pragma unroll
        for (int j = 0; j < 16; ++j) { const int p = w * 16 + j, R = p >> 1, cd = (p & 1) * 64 + lane;
            pg8::glds16s(Wg, (unsigned)(R * 2048 + ((cd ^ ((R & 3) << 2)) << 4)), lds0 + (unsigned)p * 1024u); }
        asm volatile("s_waitcnt vmcnt(0)" ::: "memory");
        __syncthreads();
        if (w < 4) {
            pg8::f32x4 a0 = (pg8::f32x4){0.f, 0.f, 0.f, 0.f}, a1 = a0; float ss = 0.f;
            unsigned char* hp = H2 + (size_t)(row0 + r) * 1024 + 8 * q;
            const LAS unsigned char* wb = wl + r * 2048; const int sw = (r & 3) << 2;
#pragma unroll
            for (int s2 = 0; s2 < 32; ++s2) {
                const v4u xw = __builtin_bit_cast(v4u, xr[s2]);
                const pg8::f32x4 xa = (pg8::f32x4){bf_lo(xw[0]), bf_hi(xw[0]), bf_lo(xw[1]), bf_hi(xw[1])}, xb = (pg8::f32x4){bf_lo(xw[2]), bf_hi(xw[2]), bf_lo(xw[3]), bf_hi(xw[3])};
                ss += (xa[0] * xa[0] + xa[1] * xa[1]) + (xa[2] * xa[2] + xa[3] * xa[3]) + (xb[0] * xb[0] + xb[1] * xb[1]) + (xb[2] * xb[2] + xb[3] * xb[3]);
                { v2u h8; h8.x = pk4_fp8(xa[0], xa[1], xa[2], xa[3]); h8.y = pk4_fp8(xb[0], xb[1], xb[2], xb[3]); *(GAS v2u*)(hp + 32 * s2) = h8; }
                const int co = ((4 * s2 + q) ^ sw) << 4;
                const bf16x8 bh0 = *(const LAS bf16x8*)(wb + co), bh1 = *(const LAS bf16x8*)(wb + 16 * 2048 + co), bl0 = *(const LAS bf16x8*)(wb + 32 * 2048 + co), bl1 = *(const LAS bf16x8*)(wb + 48 * 2048 + co);
                a0 = __builtin_amdgcn_mfma_f32_16x16x32_bf16(xr[s2], bh0, a0, 0, 0, 0); a1 = __builtin_amdgcn_mfma_f32_16x16x32_bf16(xr[s2], bh1, a1, 0, 0, 0);
                a0 = __builtin_amdgcn_mfma_f32_16x16x32_bf16(xr[s2], bl0, a0, 0, 0, 0); a1 = __builtin_amdgcn_mfma_f32_16x16x32_bf16(xr[s2], bl1, a1, 0, 0, 0);
            }
            ss += __shfl_xor(ss, 16); ss += __shfl_xor(ss, 32);
            rstd = 1.f / sqrtf(ss * (1.f / DM) + RMS_EPS);
            const float b0 = F.b_router[r], b1 = F.b_router[16 + r];
#pragma unroll
            for (int i = 0; i < 4; ++i) { const float rs = __shfl(rstd, 4 * q + i); lg[(4 * q + i) * 36 + r] = a0[i] * rs + b0; lg[(4 * q + i) * 36 + 16 + r] = a1[i] * rs + b1; }
            LDS_WAIT(); asm volatile("" ::: "memory");
            if (lane < 16) {
                float v[32];
#pragma unroll
                for (int j = 0; j < 8; ++j) { const pg8::f32x4 t4 = *(const LAS pg8::f32x4*)(lg + lane * 36 + 4 * j); v[4 * j] = t4[0]; v[4 * j + 1] = t4[1]; v[4 * j + 2] = t4[2]; v[4 * j + 3] = t4[3]; }
                unsigned taken = 0u; float tv[4];
#pragma unroll
                for (int k = 0; k < 4; ++k) { float best = -3.0e38f; int bi = 0;
#pragma unroll
                    for (int e = 0; e < 32; ++e) { const bool c = !((taken >> e) & 1u) && (v[e] > best); best = c ? v[e] : best; bi = c ? e : bi; }
                    taken |= 1u << bi; pe[k] = bi; tv[k] = best; }
                const float e1 = __expf(tv[1] - tv[0]), e2 = __expf(tv[2] - tv[0]), e3 = __expf(tv[3] - tv[0]); const float inv = 1.f / (1.f + e1 + e2 + e3);
                pw[0] = inv; pw[1] = e1 * inv; pw[2] = e2 * inv; pw[3] = e3 * inv;
#pragma unroll
                for (int k = 0; k < 4; ++k) pl[k] = __hip_atomic_fetch_add(lcnt + pe[k], 1, __ATOMIC_RELAXED, __HIP_MEMORY_SCOPE_WORKGROUP);
            }
        }
        __syncthreads();
        if (F.tid < 32) lbase[F.tid] = (int)__hip_atomic_fetch_add(F.ctl + CW_CNT + 64 * F.tid, (unsigned)lcnt[F.tid], RLX_AGENT);
        __syncthreads();
        if (w < 4 && lane < 16) { const int tok = row0 + lane;
#pragma unroll
            for (int k = 0; k < 4; ++k) { const int e = pe[k], pos = lbase[e] + pl[k]; ltok[e * CAP + pos] = tok; lgate[e * CAP + pos] = pw[k]; lrstd[e * CAP + pos] = rstd; toke[tok * 4 + k] = e; tokp[tok * 4 + k] = pos; } }
    }
}
__device__ __forceinline__ void build_tables(Frame& F) {
    __syncthreads();
    if (F.tid < 32) F.TAB[F.tid] = (int)__hip_atomic_load(F.ctl + CW_CNT + 64 * F.tid, RLX_AGENT);
    __syncthreads();
    if (F.tid <= 32) { int acc = 0; for (int e = 0; e < F.tid; ++e) acc += (F.TAB[e] + 255) >> 8; F.TAB[32 + F.tid] = acc; }
    __syncthreads();
    if (F.tid < NRT_MAX && F.tid < F.TAB[64]) { int e = 0;
#pragma unroll 1
        for (int j = 1; j < 32; ++j) e = (F.TAB[32 + j] <= F.tid) ? j : e;
        while (e > 0 && F.TAB[32 + e] == F.TAB[32 + e + 1]) --e;
        F.TAB[72 + F.tid] = e; }
    __syncthreads();
}

__device__ __forceinline__ void p8_final(Frame& F) {
    const bf16* X1 = WSP(bf16, WS_X1); const unsigned char* Y = WSP(unsigned char, WS_Y); const int* toke = WSP(int, WS_TOKE); const int* tokp = WSP(int, WS_TOKP);
    int lane = F.lane; asm volatile("" : "+v"(lane));
    const int gw = F.vcu * NWAVES + F.wave, NGW = F.G * NWAVES;
    const GAS f32x4* gp = (const GAS f32x4*)F.final_g + lane; f32x4 g[4];
#pragma unroll
    for (int j = 0; j < 4; ++j) g[j] = gp[64 * j];
    for (int m = gw; m < T_TOK; m += NGW) {
        const GAS v2u* xr = (const GAS v2u*)(X1 + (size_t)m * DM) + lane; f32x4 v[4];
#pragma unroll
        for (int j = 0; j < 4; ++j) { const v2u xw = xr[64 * j]; v[j] = (f32x4){bf_lo(xw.x), bf_hi(xw.x), bf_lo(xw.y), bf_hi(xw.y)}; }
#pragma unroll
        for (int k = 0; k < 4; ++k) { const int e = toke[m * 4 + k], pos = tokp[m * 4 + k]; const size_t slot = (size_t)F.TAB[32 + e] * 256 + pos;
            const GAS unsigned* yr = (const GAS unsigned*)(Y + slot * 1024) + lane;
#pragma unroll
            for (int j = 0; j < 4; ++j) { const unsigned yv = yr[64 * j]; const f32x2_t lo = __builtin_amdgcn_cvt_pk_f32_fp8((int)yv, false), hi = __builtin_amdgcn_cvt_pk_f32_fp8((int)yv, true);
                v[j].x += lo[0]; v[j].y += lo[1]; v[j].z += hi[0]; v[j].w += hi[1]; } }
        float s2 = 0.f;
#pragma unroll
        for (int j = 0; j < 4; ++j) s2 += (v[j].x * v[j].x + v[j].y * v[j].y) + (v[j].z * v[j].z + v[j].w * v[j].w);
        const float rstd = 1.f / sqrtf(wave_sum(s2) * (1.f / DM) + RMS_EPS);
        GAS f32x4* o = (GAS f32x4*)(F.out + (size_t)m * DM) + lane;
#pragma unroll
        for (int j = 0; j < 4; ++j) o[64 * j] = v[j] * rstd * g[j];
    }
}

struct Args { const float* in[18]; float* out; unsigned char* ws; int ph_lo, ph_hi; };
__global__ void __launch_bounds__(NWAVES * 64, 2) mk_fwd(Args args) {
    extern __shared__ __attribute__((aligned(16))) unsigned char lds[];
    Frame F;
    F.lds = (LAS unsigned char*)lds;
    F.MISC = (volatile LAS unsigned*)(F.lds + MISC_OFF);
    F.TAB = (LAS int*)(F.lds + TAB_OFF);
    F.tid = threadIdx.x; F.lane = F.tid & 63; F.wave = __builtin_amdgcn_readfirstlane(F.tid >> 6);
    F.G = gridDim.x; F.bx = (int)blockIdx.x; F.xloc = 0; F.vcu = (F.G % 8 == 0) ? (F.bx % 8) * (F.G / 8) + F.bx / 8 : F.bx;
    F.ws = args.ws; F.ctl = (gu32*)(args.ws + WS_CTL); F.out = args.out;
    F.x = args.in[0]; F.norm1_g = args.in[1]; F.w_in = args.in[2]; F.pool_w = args.in[3]; F.pool_scale = args.in[4]; F.w_pool_proj = args.in[5]; F.sinks = args.in[6]; F.w_attn_proj = args.in[7];
    F.w_out = args.in[8]; F.norm2_g = args.in[9]; F.w_router = args.in[10]; F.b_router = args.in[11]; F.w_up = args.in[12]; F.b_up = args.in[13]; F.w_down = args.in[14]; F.b_down = args.in[15];
    F.rel_bias = args.in[16]; F.final_g = args.in[17];
    for (int u = F.tid; u < (LDS_BYTES - LDSCTL_OFF) / 4; u += NWAVES * 64) ((LAS unsigned*)(F.lds + LDSCTL_OFF))[u] = 0u;
    __syncthreads();
    XcdBarrier bar; bar.bar = (unsigned*)(F.ctl + CW_BAR); bar.x = 0; bar.st = nullptr;
    if (N_LAUNCHES == 1) bar = xcd_barrier_post((unsigned*)(F.ctl + CW_BAR), F.MISC + 8);
#define GRID_BAR() do { if (N_LAUNCHES == 1) xcd_barrier(bar); } while (0)
    const int lo = args.ph_lo, hi = args.ph_hi;
#ifndef PHASE_MASK
#define PHASE_MASK 0x1ff
#endif
#define IN(k) ((((PHASE_MASK) >> (k)) & 1) && lo <= (k) && (k) < hi)
    using pg8::StaticOrder;
#ifndef REP_MASK
#define REP_MASK 0
#endif
#define REP(k) (((REP_MASK) >> (k)) & 1)
#define PH0() do { p0_prologue(F); } while (0)
#define PH1() do { { ProbDense P{(const char*)WSP(bf16, WS_H1), (const char*)WSP(bf16, WS_WIN)}; EpiInProj E{WSP(bf16, WS_U), WSP(bf16, WS_Q), WSP(bf16, WS_KV), WSP(bf16, WS_GP), WSP(bf16, WS_GA)}; \
            if (F.G == 256) { P1Order S{F.bx & 7, F.bx >> 3, 0}; pg8::gemm_phase<ProbDense, EpiInProj, P1Order, true>(F.lds + RING_OFF, P, S, E); } \
            else { StaticOrder S; S.init(T_TOK / 256, 5, F.G, F.bx); pg8::gemm_phase<ProbDense, EpiInProj, StaticOrder, true>(F.lds + RING_OFF, P, S, E); } } \
        { ProbDense8 P{(const char*)WSP(unsigned char, WS_H18), (const char*)WSP(unsigned char, WS_WIN8)}; EpiGate8 E{WSP(unsigned char, WS_GP), WSP(unsigned char, WS_GA)}; \
            if (F.G == 256) { P1Order S{F.bx & 7, F.bx >> 3, 1}; pg8::gemm_phase<ProbDense8, EpiGate8, P1Order, true>(F.lds + RING_OFF, P, S, E); } \
            else { StaticOrder S; S.init(T_TOK / 256, 8, F.G, F.bx); pg8::gemm_phase<ProbDense8, EpiGate8, StaticOrder, true>(F.lds + RING_OFF, P, S, E); } } } while (0)
#ifndef CV_A
#define CV_A 3
#endif
#ifndef CV_B
#define CV_B 5
#endif
#define STG_RANK (((F.bx >> 4) << 3) + (F.bx & 7))
#define STG_PRE_W(W_, base, cvb) do { if (F.G == 256 && ((F.bx >> 3) & 1)) convert_moe_w<W_>(F, (base), (base) + 128 * (cvb), STG_RANK, 128); } while (0)
#define STG_POST_W(W_, base, cva, cvb) do { if (F.G == 256) { if (!((F.bx >> 3) & 1)) convert_moe_w<W_>(F, (base) + 128 * (cvb), (base) + 128 * ((cva) + (cvb)), STG_RANK, 128); } \
        else convert_moe_w<W_>(F, (base), (base) + 128 * ((cva) + (cvb)), F.vcu, F.G); } while (0)
#define STG_PRE(base, cvb) STG_PRE_W(1, base, cvb)
#define STG_POST(base, cva, cvb) STG_POST_W(1, base, cva, cvb)
#ifndef CV2_A
#define CV2_A 0
#endif
#ifndef CV2_B
#define CV2_B 0
#endif
#define CV_P2BASE (2 * 128 * (CV_A + CV_B))
#define CV_P5BASE (CV_P2BASE + 128 * (CV2_A + CV2_B))
#define PH2() do { if (F.xloc) STG_PRE_W(0, 0, 2); p2_attn_pool(F); if (F.xloc) STG_POST_W(0, 0, 1, 2); } while (0)
#define PH3_PRE() STG_PRE(0, CV_B)
#define PH3_MAIN() do { { ProbDense P{(const char*)WSP(bf16, WS_ZA), (const char*)WSP(bf16, WS_WMIX)}; StaticOrder S; S.init(T_TOK / 256, DM / 256, F.G, F.bx); \
        EpiMix E{WSP(unsigned char, WS_GP), WSP(unsigned char, WS_GA), WSP(bf16, WS_MIX)}; \
        pg8::gemm_phase<ProbDense, EpiMix, StaticOrder, true>(F.lds + RING_OFF, P, S, E); } STG_POST(0, CV_A, CV_B); } while (0)
#define PH3() do { PH3_PRE(); PH3_MAIN(); } while (0)
#define PH4_PRE() STG_PRE(128 * (CV_A + CV_B), CV_B)
#define PH4_MAIN() do { { ProbDense P{(const char*)WSP(bf16, WS_MIX), (const char*)WSP(bf16, WS_WOUT)}; StaticOrder S; S.init(T_TOK / 256, DM / 256, F.G, F.bx); \
        EpiOut E{F.x, WSP(bf16, WS_X1)}; \
        pg8::gemm_phase<ProbDense, EpiOut, StaticOrder, true>(F.lds + RING_OFF, P, S, E); } STG_POST(128 * (CV_A + CV_B), CV_A, CV_B); } while (0)
#define PH4() do { PH4_PRE(); PH4_MAIN(); } while (0)
#ifndef CV5_A
#define CV5_A 2
#endif
#ifndef CV5_B
#define CV5_B 3
#endif
#define DN_P1BASE (DN_SPLIT + 128 * (CV5_A + CV5_B))
#define PH5_PRE() STG_PRE_W(0, DN_SPLIT, CV5_B)
#define PH5_MAIN() do { p5_router(F); convert_moe_w<1>(F, CV_P5BASE, NEXP * 64, F.vcu, F.G); STG_POST_W(0, DN_SPLIT, CV5_A, CV5_B); } while (0)
#define PH5() do { PH5_PRE(); PH5_MAIN(); } while (0)
#define PH6() do { ProbUp P{(const char*)WSP(bf16, WS_H2), (const char*)WSP(bf16, WS_WUP), WSP(int, WS_LTOK), F.TAB}; EpiUp E{F.b_up, WSP(float, WS_LRSTD), WSP(unsigned char, WS_ACT), F.TAB}; \
        const int nrt = __builtin_amdgcn_readfirstlane(F.TAB[64]); \
        if (F.xloc) { pg8::XccProducer S; S.init(nrt, 8, F.bx & 7, F.bx >> 3, 0); S.cnt = (unsigned*)(F.ctl + CW_RTC); pg8::gemm_phase<ProbUp, EpiUp, pg8::XccProducer, true>(F.lds + RING_OFF, P, S, E); } \
        else { StaticOrder S; S.init(nrt, 8, F.G, F.bx); pg8::gemm_phase<ProbUp, EpiUp, StaticOrder, true>(F.lds + RING_OFF, P, S, E); \
            { const int nwg = S.nwg, R = (nwg + F.G - 1) / F.G, nidle = R * F.G - nwg, c = F.bx; \
              if (nidle == 0) convert_moe_w<0>(F, 0, DN_SPLIT, c, F.G); else if (c >= F.G - nidle) convert_moe_w<0>(F, 0, DN_SPLIT, c - (F.G - nidle), nidle); } } } while (0)
#define PH7() do { ProbDown P{(const char*)WSP(bf16, WS_ACT), (const char*)WSP(bf16, WS_WDN), F.TAB}; EpiDown E{F.b_down, WSP(float, WS_LGATE), WSP(unsigned char, WS_Y), F.TAB}; \
        const int nrt = __builtin_amdgcn_readfirstlane(F.TAB[64]); \
        if (F.xloc) { pg8::XccConsumer S; { pg8::XccOrder U; U.init(nrt, 8, F.bx & 7, F.bx >> 3, 0); S.init(nrt, 4, F.bx & 7, F.bx >> 3, U.n); } S.cnt = (unsigned*)(F.ctl + CW_RTC); S.tmo = (unsigned*)(F.ctl + CW_TMO); \
            pg8::gemm_phase<ProbDown, EpiDown, pg8::XccConsumer, true>(F.lds + RING_OFF, P, S, E); } \
        else { StaticOrder S; S.init(nrt, 4, F.G, F.bx); pg8::gemm_phase<ProbDown, EpiDown, StaticOrder, true>(F.lds + RING_OFF, P, S, E); } } while (0)
#define PH8() do { p8_final(F); } while (0)
    if (IN(0)) { PH0(); GRID_BAR(); if (REP(0)) { PH0(); GRID_BAR(); } }
    if (N_LAUNCHES == 1 && lo == 0) {
        if (F.tid == 0) { int rank = 0, dense = 0; const int ok = xcc_layout(bar, rank, dense); F.MISC[12] = (unsigned)ok; F.MISC[13] = (unsigned)(rank * 8 + dense); }
        __syncthreads();
        if (F.MISC[12]) { F.xloc = 1; F.bx = (int)F.MISC[13]; F.vcu = (F.bx % 8) * (F.G / 8) + F.bx / 8; }
    }
#define LOCAL_BAR() do { if (N_LAUNCHES == 1) { if (F.xloc) xcc_barrier(bar); else xcd_barrier(bar); } } while (0)
    if (IN(1)) { PH1(); GRID_BAR(); if (REP(1)) { PH1(); GRID_BAR(); } }
#define SPLIT_SEAM(PRE) do { if (N_LAUNCHES == 1 && F.xloc) { const unsigned g_ = xcc_arrive(bar); PRE; xcc_wait(bar, g_); } else { GRID_BAR(); PRE; } } while (0)
    if (IN(2)) { PH2(); if (IN(3) && !REP(2)) SPLIT_SEAM(PH3_PRE()); else { LOCAL_BAR(); if (REP(2)) { PH2(); LOCAL_BAR(); } if (IN(3)) PH3_PRE(); } }
    if (IN(3)) { if (!IN(2)) PH3_PRE(); PH3_MAIN(); if (IN(4) && !REP(3)) SPLIT_SEAM(PH4_PRE()); else { LOCAL_BAR(); if (REP(3)) { PH3(); LOCAL_BAR(); } if (IN(4)) PH4_PRE(); } }
    if (IN(4)) { if (!IN(3)) PH4_PRE(); PH4_MAIN(); if (IN(5) && !REP(4)) SPLIT_SEAM(PH5_PRE()); else { LOCAL_BAR(); if (REP(4)) { PH4(); LOCAL_BAR(); } if (IN(5)) PH5_PRE(); } }
    if (IN(5)) { if (!IN(4)) PH5_PRE(); PH5_MAIN(); GRID_BAR(); if (REP(5)) { if (blockIdx.x == 0 && F.tid < 32) __hip_atomic_store(F.ctl + CW_CNT + 64 * F.tid, 0u, RLX_AGENT); GRID_BAR(); PH5(); GRID_BAR(); } }
    if (IN(6) || IN(7) || IN(8)) build_tables(F);
    if (IN(6)) { PH6(); if (!F.xloc) GRID_BAR(); if (REP(6)) { PH6(); GRID_BAR(); } }
    if (IN(7)) { PH7(); GRID_BAR(); if (REP(7)) { PH7(); GRID_BAR(); } }
    if (IN(8)) { PH8(); if (REP(8)) { GRID_BAR(); PH8(); } }
#undef IN
}

extern "C" void kernel_launch(void* const* d_in, const int* in_sizes, int n_in, void* d_out, int out_size, void* d_ws, size_t ws_size, hipStream_t stream) {
    static int grid = 0;
    if (grid == 0) {
        if (n_in != 18 || out_size != T_TOK * DM || ws_size < WS_END) { fprintf(stderr, "kernel_launch: unexpected problem (n_in %d out %d ws %zu)\n", n_in, out_size, ws_size); grid = -1; return; }
        int dev = 0, cus = 0, per_cu = 0;
        if (hipGetDevice(&dev) != hipSuccess || hipDeviceGetAttribute(&cus, hipDeviceAttributeMultiprocessorCount, dev) != hipSuccess) { grid = -1; return; }
        if (hipFuncSetAttribute((const void*)mk_fwd, hipFuncAttributeMaxDynamicSharedMemorySize, LDS_BYTES) != hipSuccess) { fprintf(stderr, "kernel_launch: hipFuncSetAttribute failed\n"); grid = -1; return; }
        if (hipOccupancyMaxActiveBlocksPerMultiprocessor(&per_cu, (const void*)mk_fwd, NWAVES * 64, LDS_BYTES) != hipSuccess || per_cu < 1) fprintf(stderr, "kernel_launch: occupancy query says %d\n", per_cu);
        (void)hipGetLastError();
        grid = cus;
    }
    if (grid < 0) return;
    if (hipMemsetAsync((char*)d_ws + WS_CTL, 0, CTL_ZERO_BYTES, stream) != hipSuccess) return;
    Args a{};
    for (int i = 0; i < 18; ++i) a.in[i] = (const float*)d_in[i];
    a.out = (float*)d_out; a.ws = (unsigned char*)d_ws;
    if (N_LAUNCHES == 1) { a.ph_lo = 0; a.ph_hi = PER_PHASE; hipLaunchKernelGGL(mk_fwd, dim3(grid), dim3(NWAVES * 64), LDS_BYTES, stream, a); }
    else { for (int p = 0; p < PER_PHASE; ++p) { a.ph_lo = p; a.ph_hi = p + 1; hipLaunchKernelGGL(mk_fwd, dim3(grid), dim3(NWAVES * 64), LDS_BYTES, stream, a); } }
}
```

```cpp
#include <hip/hip_runtime.h>
#include <cstdio>
#include <cstdint>

#ifndef MK_N_LAUNCHES
#define MK_N_LAUNCHES 1
#endif

constexpr int T_TOK = 16384, DM = 1024, SEQ = 4096, NB = 4;
constexpr int INW = 3328;
constexpr int NEXP = 32, TOPK = 4, DFF = 1024;
constexpr int CAP = 16384;
constexpr int NRT_MAX = 288;
constexpr int SLOT_ROWS = NRT_MAX * 256;
constexpr float RMS_EPS = 1e-5f;
constexpr float LOG2E = 1.4426950408889634f;

namespace pg8 {
#define PG8_LAS __attribute__((address_space(3)))
typedef unsigned short bf16_t;
typedef short bf16x8 __attribute__((ext_vector_type(8)));
typedef float f32x4 __attribute__((ext_vector_type(4)));
typedef float f32x2 __attribute__((ext_vector_type(2)));
typedef unsigned u32x4 __attribute__((ext_vector_type(4)));
typedef unsigned u32x2 __attribute__((ext_vector_type(2)));
constexpr int BM = 256, BK = 64, HALF = 128, HTB = HALF * BK * 2, STAGE_BYTES = 8 * HTB, NXCD = 8, WGM = 8;
constexpr int EPS_OFF = 133120 + 2048;
constexpr int GIX_OFF = 133120;
constexpr int GK = 1024;

__host__ __device__ __forceinline__ int lds_byte(int r, int c) { const int st = (r >> 4) * 2 + (c >> 5), rr = r & 15, cc = c & 31, ob = rr * 64 + cc * 2; return st * 1024 + (ob ^ (((ob >> 9) & 1) << 5)); }
__host__ __device__ __forceinline__ void stage_rc(int b, int& R, int& C) { const int st = b / 1024, sb = b % 1024, swz = sb ^ (((sb >> 9) & 1) << 5); R = (st >> 1) * 16 + swz / 64; C = (st & 1) * 32 + (swz % 64) / 2; }
__host__ __device__ __forceinline__ int perm32(int rho) { const int n = rho >> 4, i = rho & 15; return 8 * (i >> 2) + 4 * n + (i & 3); }

struct Unit { int pm, pn; };
typedef int v4i_t __attribute__((ext_vector_type(4)));
typedef int v8i_t __attribute__((ext_vector_type(8)));
__device__ __forceinline__ v8i_t cat8(bf16x8 lo, bf16x8 hi) { return __builtin_shufflevector(__builtin_bit_cast(v4i_t, lo), __builtin_bit_cast(v4i_t, hi), 0, 1, 2, 3, 4, 5, 6, 7); }

struct StaticOrder {
    static constexpr bool WAITS = false, PUBLISHES = false;
    int nM, nN, nwg, G, c;
    __host__ __device__ void init(int nM_, int nN_, int G_, int c_) { nM = nM_; nN = nN_; nwg = nM * nN; G = G_; c = c_; }
    __host__ __device__ bool next(int i, Unit& u) const {
        const long L = (long)i * G + c; if (L >= nwg) return false;
        int wgid = (int)L; { const int q = nwg / NXCD, r = nwg % NXCD, xcd = wgid % NXCD, off = wgid / NXCD; wgid = (xcd < r ? xcd * (q + 1) : r * (q + 1) + (xcd - r) * q) + off; }
        const int nig = WGM * nN, gid = wgid / nig, fm = gid * WGM, gsz = (nM - fm) < WGM ? (nM - fm) : WGM;
        u.pm = fm + ((wgid % nig) % gsz); u.pn = (wgid % nig) / gsz; return true;
    }
};

__device__ __forceinline__ void glds16s(const char* sbase, unsigned voff, unsigned lds_dst) { unsigned keep;
    asm volatile("s_mov_b32 %0, m0\n\ts_mov_b32 m0, %3\n\ts_nop 2\n\tglobal_load_lds_dwordx4 %1, %2\n\ts_mov_b32 m0, %0" : "=&s"(keep) : "v"(voff), "s"(sbase), "s"(lds_dst) : "memory"); }
struct XccOrder {
    static constexpr bool WAITS = false, PUBLISHES = false;
    int r0, nr, nN, n, skip, r;
    __host__ __device__ void init(int nM, int nN_, int x, int r_, int skip_) { r0 = x * nM / NXCD; nr = (x + 1) * nM / NXCD - r0; nN = nN_; n = nr * nN; skip = skip_; r = r_; }
    __host__ __device__ int first_i() const { return skip <= r ? 0 : (skip - r + 31) / 32; }
    __host__ __device__ bool next(int i, Unit& u) const {
        const int k = (i + first_i()) * 32 + r - skip; if (k < 0 || k >= n) return false;
        constexpr int WG = 4; const int nig = WG * nN, gid = k / nig, fm = gid * WG, gsz = (nr - fm) < WG ? (nr - fm) : WG;
        u.pm = r0 + fm + ((k % nig) % gsz); u.pn = (k % nig) / gsz; return true;
    }
};
struct XccProducer : XccOrder {
    static constexpr bool WAITS = false, PUBLISHES = true;
    unsigned* cnt;
    __device__ __forceinline__ void publish(const Unit& u) const {
        if ((threadIdx.x & 63) == 0) __hip_atomic_fetch_add(cnt + 64 * u.pm, 1u, __ATOMIC_RELAXED, __HIP_MEMORY_SCOPE_AGENT); }
};
struct XccConsumer : XccOrder {
    static constexpr bool WAITS = true, PUBLISHES = false;
    unsigned* cnt; unsigned* tmo;
    __device__ __forceinline__ void a_probe(const Unit& u, unsigned& pv) const {
        pv = 0u;
        if (threadIdx.x < 64) { const unsigned* p = cnt + 64 * u.pm; const unsigned z = 0u; asm volatile("global_load_dword %0, %1, %2 sc1" : "+v"(pv) : "v"(z), "s"(p) : "memory"); } }
    __device__ __forceinline__ void a_ready_probed(const Unit& u, unsigned& pv) const {
        if (threadIdx.x < 64) {
            asm volatile("" : "+v"(pv));
            if ((unsigned)__builtin_amdgcn_readfirstlane(pv) < 64u) {
                unsigned sp = 0u;
                while ((unsigned)__builtin_amdgcn_readfirstlane(__hip_atomic_load(cnt + 64 * u.pm, __ATOMIC_RELAXED, __HIP_MEMORY_SCOPE_AGENT)) < 64u) {
                    __builtin_amdgcn_s_sleep(2);
                    if ((++sp & 255u) == 0u) { if (__builtin_amdgcn_readfirstlane(__hip_atomic_load(tmo, __ATOMIC_RELAXED, __HIP_MEMORY_SCOPE_AGENT)) != 0u) break;
                        if (sp > (1u << 20)) { if (threadIdx.x == 0) __hip_atomic_store(tmo, 1u, __ATOMIC_RELAXED, __HIP_MEMORY_SCOPE_AGENT); break; } } }
                asm volatile("s_waitcnt vmcnt(0)" ::: "memory"); }
            asm volatile("buffer_inv sc0" ::: "memory");
        }
        asm volatile("" ::: "memory"); __builtin_amdgcn_s_barrier(); asm volatile("" ::: "memory");
    }
    __device__ __forceinline__ void a_ready(const Unit& u) const {
        if (threadIdx.x < 64) {
            unsigned sp = 0u;
            while ((unsigned)__builtin_amdgcn_readfirstlane(__hip_atomic_load(cnt + 64 * u.pm, __ATOMIC_RELAXED, __HIP_MEMORY_SCOPE_AGENT)) < 64u) {
                __builtin_amdgcn_s_sleep(2);
                if ((++sp & 255u) == 0u) { if (__builtin_amdgcn_readfirstlane(__hip_atomic_load(tmo, __ATOMIC_RELAXED, __HIP_MEMORY_SCOPE_AGENT)) != 0u) break;
                    if (sp > (1u << 20)) { if (threadIdx.x == 0) __hip_atomic_store(tmo, 1u, __ATOMIC_RELAXED, __HIP_MEMORY_SCOPE_AGENT); break; } } }
            asm volatile("buffer_inv sc0" ::: "memory");
            asm volatile("s_waitcnt vmcnt(0)" ::: "memory");
        }
        asm volatile("" ::: "memory"); __builtin_amdgcn_s_barrier(); asm volatile("" ::: "memory");
    }
};
__device__ __forceinline__ unsigned cvt_pk_bf16(float lo, float hi) { unsigned r; asm volatile("v_cvt_pk_bf16_f32 %0, %1, %2" : "=v"(r) : "v"(lo), "v"(hi)); return r; }
__device__ __forceinline__ float bf_lo(unsigned w) { return __uint_as_float(w << 16); }
__device__ __forceinline__ float bf_hi(unsigned w) { return __uint_as_float(w & 0xffff0000u); }

template <class Prob, class Epi, class Sched, bool ALIGN_EPI>
__device__ __forceinline__ void gemm_phase(PG8_LAS unsigned char* lds, const Prob& P, const Sched& S, const Epi& E) {
    const int tid = threadIdx.x, wid = __builtin_amdgcn_readfirstlane(tid >> 6), lane = tid & 63, wr = wid >> 2, wc = wid & 3, fr = lane & 15, fq = lane >> 4;
    constexpr bool FP8 = Prob::FP8;
    constexpr int RB = FP8 ? GK : GK * 2;
    constexpr int nt = FP8 ? GK / 128 : GK / BK;
    unsigned voffA[2], voffB[2];
#pragma unroll
    for (int i = 0; i < 2; ++i) { int R, C; stage_rc(tid * 16 + i * 8192, R, C); const int Rb = Epi::PERM ? ((R & ~31) + perm32(R & 31)) : R;
        voffA[i] = (unsigned)(R * RB + C * 2); voffB[i] = (unsigned)(Rb * RB + C * 2); }
#define PG8_GIX_SLOT(j) (lds + GIX_OFF + ((j) & 1) * 1024)
#define PG8_GATHER_STAGE(u, j) do { if (wid == 0) glds16s(P.gather_src(u), (unsigned)lane * 16u, lds0 + (unsigned)GIX_OFF + (unsigned)(((j) & 1) * 1024)); } while (0)
#define PG8_GATHER_LOAD(j, G_) do { int tid_ = tid; asm volatile("" : "+v"(tid_)); _Pragma("unroll") for (int i = 0; i < 2; ++i) { int R, C; stage_rc(tid_ * 16 + i * 8192, R, C); \
        const unsigned g0_ = *(const PG8_LAS unsigned*)(PG8_GIX_SLOT(j) + R * 4), g1_ = *(const PG8_LAS unsigned*)(PG8_GIX_SLOT(j) + (HALF + R) * 4); \
        G_[i] = g0_ < Prob::GMAX ? g0_ : Prob::GMAX; G_[2 + i] = g1_ < Prob::GMAX ? g1_ : Prob::GMAX; } } while (0)
#define PG8_GATHER_OFFS(G_, D0, D1) do { int tid_ = tid; asm volatile("" : "+v"(tid_)); _Pragma("unroll") for (int i = 0; i < 2; ++i) { int R, C; stage_rc(tid_ * 16 + i * 8192, R, C); \
        D0[i] = G_[i] * (unsigned)RB + (unsigned)(C * 2); D1[i] = G_[2 + i] * (unsigned)RB + (unsigned)(C * 2); } } while (0)
    constexpr size_t kstep = (size_t)(BK * 2);
    constexpr size_t hstep = (size_t)HALF * RB;
    const unsigned ldsw = (unsigned)wid * 1024u, lds0 = (unsigned)(uintptr_t)lds;
    const int aoff = lds_byte(wr * 64 + fr, fq * 8), boff = lds_byte(wc * 32 + fr, fq * 8);
#define PG8_SA(b, h) (((b) * 2 + (h)) * HTB)
#define PG8_SB(b, h) ((4 + (b) * 2 + (h)) * HTB)
#define PG8_STAGE(bufoff, gbase, voff) do { _Pragma("unroll") for (int _i = 0; _i < 2; ++_i) glds16s((const char*)(gbase), (voff)[_i], lds0 + (unsigned)(bufoff) + ldsw + (unsigned)(_i * 8192)); } while (0)
#define PG8_STAGE_A(b, h, gbase, VOG) do { if constexpr (Prob::GATHER) { PG8_STAGE(PG8_SA(b, h), (gbase), VOG); } else { PG8_STAGE(PG8_SA(b, h), (gbase) + (h) * hstep, voffA); } } while (0)
#define PG8_LDA(dst, b, h) do { _Pragma("unroll") for (int m = 0; m < 4; ++m) { if constexpr (FP8) { dst##8[m] = cat8(*(const PG8_LAS bf16x8*)(lds + PG8_SA(b, h) + aoff + m * 2048), *(const PG8_LAS bf16x8*)(lds + PG8_SA(b, h) + aoff + m * 2048 + 1024)); } \
        else { _Pragma("unroll") for (int k = 0; k < 2; ++k) dst[m][k] = *(const PG8_LAS bf16x8*)(lds + PG8_SA(b, h) + aoff + m * 2048 + k * 1024); } } } while (0)
#define PG8_LDB(dst, b, h) do { _Pragma("unroll") for (int n = 0; n < 2; ++n) { if constexpr (FP8) { dst##8[n] = cat8(*(const PG8_LAS bf16x8*)(lds + PG8_SB(b, h) + boff + n * 2048), *(const PG8_LAS bf16x8*)(lds + PG8_SB(b, h) + boff + n * 2048 + 1024)); } \
        else { _Pragma("unroll") for (int k = 0; k < 2; ++k) dst[n][k] = *(const PG8_LAS bf16x8*)(lds + PG8_SB(b, h) + boff + n * 2048 + k * 1024); } } } while (0)
#define PG8_MMA(ai, bj, At, Bt) do { __builtin_amdgcn_s_setprio(1); _Pragma("unroll") for (int m = 0; m < 4; ++m) _Pragma("unroll") for (int n = 0; n < 2; ++n) { \
        if constexpr (FP8) { asm volatile("v_mfma_f32_16x16x128_f8f6f4 %0, %1, %2, %0" : "+v"(acc[ai][bj][m][n]) : "v"(Bt##8[n]), "v"(At##8[m])); } \
        else { _Pragma("unroll") for (int k = 0; k < 2; ++k) acc[ai][bj][m][n] = __builtin_amdgcn_mfma_f32_16x16x32_bf16(Bt[n][k], At[m][k], acc[ai][bj][m][n], 0, 0, 0); } } \
        __builtin_amdgcn_s_setprio(0); } while (0)
#define PG8_WAIT_V(n) asm volatile("s_waitcnt vmcnt(" #n ")" ::: "memory")
#define PG8_WAIT_L(n) asm volatile("s_waitcnt lgkmcnt(" #n ")" ::: "memory")
#define PG8_BAR __builtin_amdgcn_s_barrier()
#define PG8_SCHED __builtin_amdgcn_sched_barrier(0)
    Unit cur, nxt; int ui = 0;
    if (!S.next(0, cur)) return;
    f32x4 acc[2][2][4][2];
#pragma unroll
    for (int a = 0; a < 2; ++a)
#pragma unroll
        for (int b = 0; b < 2; ++b)
#pragma unroll
            for (int m = 0; m < 4; ++m)
#pragma unroll
                for (int n = 0; n < 2; ++n) acc[a][b][m][n] = (f32x4){0.f, 0.f, 0.f, 0.f};
    bf16x8 At[4][2], B0[2][2], B1[2][2]; v8i_t At8[4], B08[2], B18[2]; typename Epi::Pre pre;
    const char* cA = P.a_tile(cur); const char* cB = P.b_tile(cur); Unit prv = cur;
    PG8_STAGE(PG8_SB(0, 0), cB, voffB); PG8_STAGE(PG8_SB(0, 1), cB + hstep, voffB);
    if constexpr (Sched::WAITS) S.a_ready(cur);
    unsigned vA0[2] = {0u, 0u}, vA1[2] = {0u, 0u}, vL1[2] = {0u, 0u};
    unsigned gix[4] = {0u, 0u, 0u, 0u}; unsigned probe = 0u;
    if constexpr (Prob::GATHER) { PG8_GATHER_STAGE(cur, 0); PG8_WAIT_V(0); PG8_BAR; PG8_GATHER_LOAD(0, gix); PG8_GATHER_OFFS(gix, vA0, vA1); vL1[0] = vA1[0]; vL1[1] = vA1[1]; }
    PG8_STAGE_A(0, 0, cA, vA0); PG8_STAGE_A(0, 1, cA, vA1);
    if (wr == 1) PG8_BAR;
    PG8_WAIT_V(2); PG8_BAR;
    PG8_STAGE(PG8_SB(1, 0), cB + kstep, voffB); PG8_STAGE_A(1, 0, cA + kstep, vA0); PG8_STAGE(PG8_SB(1, 1), cB + hstep + kstep, voffB);
    PG8_WAIT_V(6); PG8_BAR;
    for (;;) {
        const bool has_next = S.next(ui + 1, nxt);
        const char* nA = has_next ? P.a_tile(nxt) : cA; const char* nB = has_next ? P.b_tile(nxt) : cB;
        constexpr int NSEG = (Epi::MID > 0) ? 2 : 1;
#pragma unroll
        for (int seg = 0; seg < NSEG; ++seg) {
        if constexpr (Epi::MID > 0) { if (seg == 1) E.mid(acc, cur, wr, wc, fr, fq); }
        const int t_lo = (seg == 0) ? 0 : Epi::MID, t_hi = (Epi::MID > 0 && seg == 0) ? Epi::MID : nt;
#pragma unroll 1
        for (int t = t_lo; t < t_hi; t += 2) {
            const bool last = (t == nt - 2);
            const char* a1 = cA + (size_t)(t + 1) * kstep;
            const char* a2 = last ? nA : cA + (size_t)(t + 2) * kstep; const char* b2 = last ? nB : cB + (size_t)(t + 2) * kstep;
            const char* a3 = a2 + kstep; const char* b3 = b2 + kstep;
            if constexpr (Sched::WAITS) { if (has_next) { if (t == nt - 4) S.a_probe(nxt, probe); if (last) S.a_ready_probed(nxt, probe); } }
            if constexpr (Prob::GATHER) { if (has_next) { if (t == 0) { PG8_GATHER_STAGE(nxt, ui + 1); } if (last) { PG8_GATHER_LOAD(ui + 1, gix); PG8_GATHER_OFFS(gix, vA0, vA1); } } }
            if constexpr (Epi::PREFETCH) { if (t == 0) E.stage(pre, cur, ui, wid, lane, lds0); }
            PG8_LDB(B0, 0, 0); PG8_LDB(B1, 0, 1); PG8_SCHED; PG8_LDA(At, 0, 0); PG8_STAGE_A(1, 1, a1, vL1);
            PG8_WAIT_V(8); PG8_WAIT_L(0); PG8_BAR; PG8_MMA(0, 0, At, B0); PG8_MMA(0, 1, At, B1); PG8_BAR; PG8_SCHED;
            PG8_LDA(At, 0, 1); PG8_STAGE(PG8_SB(0, 0), b2, voffB); PG8_STAGE(PG8_SB(0, 1), b2 + hstep, voffB); PG8_STAGE_A(0, 0, a2, vA0);
            PG8_WAIT_V(8); PG8_WAIT_L(0); PG8_BAR; PG8_MMA(1, 0, At, B0); PG8_MMA(1, 1, At, B1); PG8_BAR; PG8_SCHED;
            PG8_LDB(B0, 1, 0); PG8_LDB(B1, 1, 1); PG8_SCHED; PG8_LDA(At, 1, 0); PG8_STAGE_A(0, 1, a2, vA1);
            PG8_WAIT_V(8); PG8_WAIT_L(0); PG8_BAR; PG8_MMA(0, 0, At, B0); PG8_MMA(0, 1, At, B1); PG8_BAR; PG8_SCHED;
            PG8_LDA(At, 1, 1); PG8_STAGE(PG8_SB(1, 0), b3, voffB); PG8_STAGE(PG8_SB(1, 1), b3 + hstep, voffB); PG8_STAGE_A(1, 0, a3, vA0);
            PG8_WAIT_V(8); PG8_WAIT_L(0); PG8_BAR; PG8_MMA(1, 0, At, B0); PG8_MMA(1, 1, At, B1); PG8_BAR; PG8_SCHED;
        }
        }
        if constexpr (ALIGN_EPI) { if (wr == 0) PG8_BAR; }
        if constexpr (Sched::PUBLISHES) { if (ui > 0) { PG8_WAIT_V(8); S.publish(prv); } }
        if constexpr (FP8) asm volatile("s_nop 15\n\ts_nop 15" ::: "memory");
        { int fr_ = fr, fq_ = fq; asm volatile("" : "+v"(fr_), "+v"(fq_) :: "memory");
          E(acc, pre, cur, wr, wc, fr_, fq_); }
        if (!has_next) break;
#pragma unroll
        for (int a = 0; a < 2; ++a)
#pragma unroll
            for (int b = 0; b < 2; ++b)
#pragma unroll
                for (int m = 0; m < 4; ++m)
#pragma unroll
                    for (int n = 0; n < 2; ++n) acc[a][b][m][n] = (f32x4){0.f, 0.f, 0.f, 0.f};
        prv = cur; cur = nxt; cA = nA; cB = nB; ++ui;
        if constexpr (Prob::GATHER) { vL1[0] = vA1[0]; vL1[1] = vA1[1]; }
        if constexpr (ALIGN_EPI) { if (wr == 1) PG8_BAR; }
    }
    PG8_WAIT_V(0);
    if constexpr (Sched::PUBLISHES) S.publish(cur);
    if constexpr (!ALIGN_EPI) { if (wr == 0) PG8_BAR; }
    PG8_BAR;
#undef PG8_SA
#undef PG8_SB
#undef PG8_STAGE
#undef PG8_STAGE_A
#undef PG8_GATHER_OFFS
#undef PG8_GATHER_LOAD
#undef PG8_GATHER_STAGE
#undef PG8_GIX_SLOT
#undef PG8_LDA
#undef PG8_LDB
#undef PG8_MMA
#undef PG8_WAIT_V
#undef PG8_WAIT_L
#undef PG8_BAR
#undef PG8_SCHED
}
}

constexpr int NWAVES = 8;
constexpr int N_LAUNCHES = MK_N_LAUNCHES;
constexpr int PER_PHASE = 9;

constexpr size_t MiB = 1u << 20;
constexpr size_t WS_CTL = 0, CTL_ZERO_BYTES = 1 * MiB;
constexpr size_t WS_WIN = 2 * MiB;
constexpr size_t WS_WMIX = 10 * MiB;
constexpr size_t WS_WOUT = 12 * MiB;
constexpr size_t WS_WRT = 14 * MiB;
constexpr size_t WS_WUP = 16 * MiB;
constexpr size_t WS_WDN = 144 * MiB;
constexpr size_t WS_H1 = 208 * MiB;
constexpr size_t WS_U = 240 * MiB;
constexpr size_t WS_Q = 256 * MiB;
constexpr size_t WS_KV = 272 * MiB;
constexpr size_t WS_GP = 280 * MiB;
constexpr size_t WS_GA = 312 * MiB;
constexpr size_t WS_ZA = 344 * MiB;
constexpr size_t WS_MIX = 376 * MiB;
constexpr size_t WS_X1 = 408 * MiB;
constexpr size_t WS_H2 = 472 * MiB;
constexpr size_t WS_LTOK = 504 * MiB;
constexpr size_t WS_LGATE = 506 * MiB;
constexpr size_t WS_LRSTD = 508 * MiB;
constexpr size_t WS_TOKE = 510 * MiB;
constexpr size_t WS_TOKP = 511 * MiB;
constexpr size_t WS_ACT = 512 * MiB;
constexpr size_t WS_Y = 656 * MiB;
constexpr size_t WS_H18 = 800 * MiB;
constexpr size_t WS_WIN8 = 816 * MiB;
constexpr size_t WS_END = 820 * MiB;
constexpr int CW_TMO = 0, CW_CODE = 1;
constexpr int CW_CNT = 1024;
constexpr int CW_BAR = 4096;
constexpr int CW_RTC = 32768;

constexpr int RING_OFF = 0, RING_BYTES = 131072;
constexpr int LDSCTL_OFF = RING_BYTES, MISC_OFF = LDSCTL_OFF + 320;
constexpr int TAB_OFF = MISC_OFF + 128;
constexpr int LDS_BYTES = 147456;
static_assert(TAB_OFF + (32 + 40 + NRT_MAX) * 4 <= LDS_BYTES, "LDS map");

#define GAS __attribute__((address_space(1)))
#define LAS __attribute__((address_space(3)))
typedef unsigned short bf16;
typedef unsigned v4u __attribute__((ext_vector_type(4)));
typedef unsigned v2u __attribute__((ext_vector_type(2)));
typedef float f32x4 __attribute__((ext_vector_type(4)));
typedef float f32x16 __attribute__((ext_vector_type(16)));
typedef short bf16x8 __attribute__((ext_vector_type(8)));
typedef GAS unsigned gu32;
#define RLX_AGENT __ATOMIC_RELAXED, __HIP_MEMORY_SCOPE_AGENT
#define LDS_WAIT() asm volatile("s_waitcnt lgkmcnt(0)" ::: "memory")
#define VM_WAIT() asm volatile("s_waitcnt vmcnt(0)" ::: "memory")
__device__ __forceinline__ unsigned f2bf(float f) { unsigned u = __builtin_bit_cast(unsigned, f); return (u + 0x7fffu + ((u >> 16) & 1u)) >> 16; }
__device__ __forceinline__ unsigned pk2(float lo, float hi) { return f2bf(lo) | (f2bf(hi) << 16); }
using pg8::cvt_pk_bf16; using pg8::bf_lo; using pg8::bf_hi;
typedef float f32x2_t __attribute__((ext_vector_type(2)));
typedef __bf16 bf16x2_t __attribute__((ext_vector_type(2)));
__device__ __forceinline__ unsigned cvtpk_s(float lo, float hi) { f32x2_t v = {lo, hi}; bf16x2_t b = __builtin_convertvector(v, bf16x2_t); return __builtin_bit_cast(unsigned, b); }

constexpr float W8_SCALE = 256.0f, W8_INV = 1.0f / 256.0f;
__device__ __forceinline__ float sat8(float x) { return __builtin_amdgcn_fmed3f(x, -448.f, 448.f); }
__device__ __forceinline__ unsigned pk4_fp8(float a, float b, float c, float d) { int w = 0; w = __builtin_amdgcn_cvt_pk_fp8_f32(sat8(a), sat8(b), w, false); w = __builtin_amdgcn_cvt_pk_fp8_f32(sat8(c), sat8(d), w, true); return (unsigned)w; }
#define XB_TMO      128
#define XB_XCNT(j)  (256  + 64 * (j))
#define XB_XSUB(j)  (1280 + 64 * (j))
#define XB_XGEN(j)  (2304 + 64 * (j))
#define XB_TOP      3328
#define XB_TOPGEN   3392
#define XCD_BAR_WORDS 3456
#define XB_LSUB(j)  (4096 + 64 * (j))
#define XB_LGEN(j)  (5120 + 64 * (j))
#define XB_SPIN_CAP (1u << 18)
__device__ __forceinline__ unsigned xb_ld(unsigned* p)              { return __hip_atomic_load(p, __ATOMIC_RELAXED, __HIP_MEMORY_SCOPE_AGENT); }
__device__ __forceinline__ unsigned xb_add(unsigned* p, unsigned v) { return __hip_atomic_fetch_add(p, v, __ATOMIC_RELAXED, __HIP_MEMORY_SCOPE_AGENT); }
__device__ __forceinline__ unsigned xb_xcc_id() { return (unsigned)__builtin_amdgcn_s_getreg((3 << 11) | 20) & 0xFu; }
#define XB_SPIN(cond, bar) do { unsigned _sp = 0; while (cond) { __builtin_amdgcn_s_sleep(1); \
    if ((++_sp & 255u) == 0u) { if (xb_ld(&(bar)[XB_TMO])) break; if (_sp > XB_SPIN_CAP) { atomicAdd(&(bar)[XB_TMO], 1u); break; } } } } while (0)
struct XcdBarrier { unsigned* bar; unsigned x; volatile LAS unsigned* st; };
__device__ __forceinline__ XcdBarrier xcd_barrier_post(unsigned* bar, volatile LAS unsigned* st) {
    XcdBarrier b; b.bar = bar; b.x = xb_xcc_id(); b.st = st;
    if (threadIdx.x == 0) st[2] = xb_add(&bar[XB_XCNT(b.x)], 1u);
    return b;
}
__device__ __forceinline__ void xcc_barrier(const XcdBarrier& b) {
    asm volatile("s_waitcnt vmcnt(0)" ::: "memory");
    __syncthreads();
    if (threadIdx.x == 0) {
        unsigned* bar = b.bar; const unsigned nloc = b.st[0];
        const unsigned old = xb_add(&bar[XB_LSUB(b.x)], 1u), gen = old / nloc;
        if (old + 1u == (gen + 1u) * nloc) xb_add(&bar[XB_LGEN(b.x)], 1u);
        else XB_SPIN(xb_ld(&bar[XB_LGEN(b.x)]) == gen, bar);
        asm volatile("buffer_inv sc0" ::: "memory");
        asm volatile("s_waitcnt vmcnt(0)" ::: "memory");
    }
    __syncthreads();
}
__device__ __forceinline__ unsigned xcc_arrive(const XcdBarrier& b) {
    asm volatile("s_waitcnt vmcnt(0)" ::: "memory");
    __syncthreads();
    unsigned gen = 0u;
    if (threadIdx.x == 0) { unsigned* bar = b.bar; const unsigned nloc = b.st[0]; const unsigned old = xb_add(&bar[XB_LSUB(b.x)], 1u); gen = old / nloc;
        if (old + 1u == (gen + 1u) * nloc) xb_add(&bar[XB_LGEN(b.x)], 1u); }
    return gen;
}
__device__ __forceinline__ void xcc_wait(const XcdBarrier& b, unsigned gen) {
    if (threadIdx.x == 0) { unsigned* bar = b.bar;
        XB_SPIN(xb_ld(&bar[XB_LGEN(b.x)]) == gen, bar);
        asm volatile("buffer_inv sc0" ::: "memory");
        asm volatile("s_waitcnt vmcnt(0)" ::: "memory"); }
    __syncthreads();
}
__device__ __forceinline__ int xcc_layout(const XcdBarrier& b, int& rank, int& dense) {
    unsigned* bar = b.bar; unsigned nx = 0u, lower = 0u; bool even = true; const unsigned mine = xb_ld(&bar[XB_XCNT(b.x)]);
#pragma unroll
    for (unsigned j = 0; j < 16; ++j) { const unsigned c = xb_ld(&bar[XB_XCNT(j)]); if (c) { ++nx; if (j < b.x) ++lower; if (c != mine) even = false; } }
    rank = (int)b.st[2]; dense = (int)lower;
    return (even && nx == 8u && mine == 32u && rank < 32) ? 1 : 0;
}
__device__ __forceinline__ void xcd_barrier_complete(unsigned* bar, unsigned x, unsigned& nloc, unsigned& nx) {
    const unsigned G = gridDim.x * gridDim.y * gridDim.z;
    unsigned sum, cnt, mine, sp = 0u;
    for (;;) {
        sum = 0u; cnt = 0u; mine = 0u;
#pragma unroll
        for (unsigned j = 0; j < 16; ++j) { const unsigned c = xb_ld(&bar[XB_XCNT(j)]); sum += c; cnt += (c > 0u) ? 1u : 0u; mine = (j == x) ? c : mine; }
        if (sum == G) break;
        __builtin_amdgcn_s_sleep(1);
        if ((++sp & 255u) == 0u) { if (xb_ld(&bar[XB_TMO])) break; if (sp > XB_SPIN_CAP) { atomicAdd(&bar[XB_TMO], 1u); break; } }
    }
    nloc = mine > 0u ? mine : 1u; nx = cnt > 0u ? cnt : 1u;
}
__device__ __forceinline__ void xcd_barrier(const XcdBarrier& b) {
    asm volatile("s_waitcnt vmcnt(0)" ::: "memory");
    __syncthreads();
    if (threadIdx.x == 0) {
        unsigned* bar = b.bar;
        __builtin_amdgcn_s_waitcnt(0);
        unsigned nloc = b.st[0], nx = b.st[1];
        if (nloc == 0u) { xcd_barrier_complete(bar, b.x, nloc, nx); b.st[0] = nloc; b.st[1] = nx; }
        const unsigned old = xb_add(&bar[XB_XSUB(b.x)], 1u);
        const unsigned gen = old / nloc;
        if (old + 1u == (gen + 1u) * nloc) {
            __builtin_amdgcn_fence(__ATOMIC_RELEASE, "agent");
            asm volatile("s_waitcnt vmcnt(0)" ::: "memory");
            const unsigned og = xb_add(&bar[XB_TOP], 1u);
            const unsigned tg = og / nx;
            if (og + 1u == (tg + 1u) * nx) xb_add(&bar[XB_TOPGEN], 1u);
            else XB_SPIN(xb_ld(&bar[XB_TOPGEN]) == tg, bar);
            __builtin_amdgcn_fence(__ATOMIC_ACQUIRE, "agent");
            asm volatile("s_waitcnt vmcnt(0)" ::: "memory");
            xb_add(&bar[XB_XGEN(b.x)], 1u);
            asm volatile("s_waitcnt vmcnt(0)" ::: "memory");
        } else {
            XB_SPIN(xb_ld(&bar[XB_XGEN(b.x)]) == gen, bar);
            asm volatile("buffer_inv sc0" ::: "memory");
            asm volatile("s_waitcnt vmcnt(0)" ::: "memory");
        }
    }
    __syncthreads();
}

struct Frame {
    LAS unsigned char* lds;
    volatile LAS unsigned* MISC;
    LAS int* TAB;
    gu32* ctl;
    int tid, lane, wave;
    int vcu, G, bx, xloc;
    const float *x, *norm1_g, *w_in, *pool_w, *pool_scale, *w_pool_proj, *sinks, *w_attn_proj, *w_out, *norm2_g, *w_router, *b_router, *w_up, *b_up, *w_down, *b_down, *rel_bias, *final_g;
    float* out;
    unsigned char* ws;
};
#define WSP(T_, off) ((T_*)(F.ws + (off)))

__device__ __forceinline__ float wave_sum(float v) {
#pragma unroll
    for (int o = 1; o < 64; o <<= 1) v += __shfl_xor(v, o);
    return v;
}

template <int MAP  >
__device__ __forceinline__ void p0_transpose_item(const float* W, int N, bf16* WT, int ldt, int koff, LAS float* scr, int item, int lane, int nb_used = 0, int nb_split = 0, int nb_skip = 0) {
    const int nblk = nb_used ? nb_used : N / 32, kb = item / nblk, nb_ = item % nblk, nb = (nb_used && nb_ >= nb_split) ? nb_ + nb_skip : nb_, k0 = 64 * kb, n0 = 32 * nb;
    float v[32];
#pragma unroll
    for (int i = 0; i < 32; ++i) { const int kk = 2 * i + (lane >> 5); v[i] = W[(size_t)(k0 + kk) * N + n0 + (lane & 31)]; }
#pragma unroll
    for (int i = 0; i < 32; ++i) { const int kk = 2 * i + (lane >> 5); scr[kk * 33 + (lane & 31)] = v[i]; }
    LDS_WAIT(); asm volatile("" ::: "memory");
    const int c = lane & 7;
#pragma unroll
    for (int j = 0; j < 4; ++j) { const int n = (lane >> 3) + 8 * j; const LAS float* s = scr + (8 * c) * 33 + n;
        v4u o; o.x = pk2(s[0 * 33], s[1 * 33]); o.y = pk2(s[2 * 33], s[3 * 33]); o.z = pk2(s[4 * 33], s[5 * 33]); o.w = pk2(s[6 * 33], s[7 * 33]);
        int nn = n0 + n;
        if (MAP == 1) { const int pn = nn >> 8, rem = nn & 255; nn = (pn << 8) + ((rem & 1) << 7) + (rem >> 1); }
        *(GAS v4u*)(WT + (size_t)nn * ldt + koff + k0 + 8 * c) = o; }
    LDS_WAIT(); asm volatile("" ::: "memory");
}
struct Fp8Src { const float* W; int N; unsigned char* WT; int item; const float* g; int ld; };
__device__ __forceinline__ void fp8_tile_load(Frame& F, const Fp8Src& S, f32x4 (&v)[16]) {
    const int nblk = S.N / 256, kb = S.item / nblk, nb = S.item % nblk;
    const float* src = S.W + (size_t)(128 * kb + 16 * F.wave) * S.ld + 256 * nb + 4 * F.lane;
#pragma unroll
    for (int i = 0; i < 16; ++i) v[i] = __builtin_nontemporal_load((const GAS f32x4*)(src + (size_t)i * S.ld));
}
__device__ __forceinline__ void fp8_tile_pack(Frame& F, const Fp8Src& S, const f32x4 (&v)[16], v4u (&o)[4]) {
    float sc[16]; const int kr = 128 * (S.item / (S.N / 256)) + 16 * F.wave;
#pragma unroll
    for (int i = 0; i < 16; ++i) sc[i] = S.g ? S.g[kr + i] * W8_SCALE : W8_SCALE;
#pragma unroll
    for (int j = 0; j < 4; ++j)
#pragma unroll
        for (int q = 0; q < 4; ++q) o[j][q] = pk4_fp8(v[4 * q][j] * sc[4 * q], v[4 * q + 1][j] * sc[4 * q + 1], v[4 * q + 2][j] * sc[4 * q + 2], v[4 * q + 3][j] * sc[4 * q + 3]);
}
template <int MAP>
__device__ __forceinline__ void fp8_tile_store(Frame& F, const Fp8Src& S, const v4u (&o)[4]) {
    const int nblk = S.N / 256, kb = S.item / nblk, nb = S.item % nblk, k0 = 128 * kb, n0 = 256 * nb, lane = F.lane, w = F.wave;
    LAS unsigned char* tile = F.lds + RING_OFF;
    __syncthreads();
#pragma unroll
    for (int j = 0; j < 4; ++j) { const int row = 4 * lane + j; *(LAS v4u*)(tile + row * 128 + ((w ^ (lane & 7)) << 4)) = o[j]; }
    __syncthreads();
#pragma unroll
    for (int i = 0; i < 4; ++i) { const int row = (F.tid >> 3) + 64 * i, c = F.tid & 7; const v4u t = *(const LAS v4u*)(tile + row * 128 + ((c ^ ((row >> 2) & 7)) << 4));
        int nn = n0 + row; if (MAP == 1) { const int pn = nn >> 8, rem = nn & 255; nn = (pn << 8) + ((rem & 1) << 7) + (rem >> 1); }
        *(GAS v4u*)(S.WT + (size_t)nn * 1024 + k0 + 16 * c) = t; }
}
template <int WHICH>
__device__ __forceinline__ void convert_moe_w(Frame& F, int lo, int hi, int first, int nblk) {
    constexpr int NW = WHICH ? 2048 : DM, I1 = (DM / 128) * (NW / 256);
    const float* Wsrc = WHICH ? F.w_up : F.w_down; unsigned char* Wdst = WHICH ? WSP(unsigned char, WS_WUP) : WSP(unsigned char, WS_WDN);
    f32x4 v[16]; int it = lo + first;
    Fp8Src cur{nullptr, NW, nullptr, 0, WHICH ? F.norm2_g : nullptr, NW};
    if (it < hi) { const int e = it / I1; cur.W = Wsrc + (size_t)e * DM * NW; cur.WT = Wdst + (size_t)e * NW * DM; cur.item = it % I1; fp8_tile_load(F, cur, v); }
    while (it < hi) {
        v4u o[4]; fp8_tile_pack(F, cur, v, o);
        const int nx = it + nblk; Fp8Src nxt = cur;
        if (nx < hi) { const int e = nx / I1; nxt.W = Wsrc + (size_t)e * DM * NW; nxt.WT = Wdst + (size_t)e * NW * DM; nxt.item = nx % I1; fp8_tile_load(F, nxt, v); }
        fp8_tile_store<WHICH>(F, cur, o);
        cur = nxt; it = nx;
    }
    __syncthreads();
}
#ifndef DN_SPLIT
#define DN_SPLIT 384
#endif
__device__ __forceinline__ void convert_win8(Frame& F) {
    f32x4 v[16];
    for (int it = (F.vcu + 80) % F.G; it < 80; it += F.G) { Fp8Src S{
       F.w_in + 1280, 2048, WSP(unsigned char, WS_WIN8), it, nullptr, INW};
        if (it >= 64) { S.W = F.w_in + 512; S.N = 512; S.WT = WSP(unsigned char, WS_WIN8) + (size_t)2048 * 1024; S.item = it - 64; }
        fp8_tile_load(F, S, v); v4u o[4]; fp8_tile_pack(F, S, v, o); fp8_tile_store<0>(F, S, o); }
    __syncthreads();
}
__device__ __forceinline__ void p0_prologue(Frame& F) {
    LAS float* scr = (LAS float*)(F.lds + RING_OFF + F.wave * 16384);
    const int gw = F.vcu * NWAVES + F.wave, NGW = F.G * NWAVES, lane = F.lane;
    bf16* Win_t = WSP(bf16, WS_WIN); bf16* Wmix_t = WSP(bf16, WS_WMIX); bf16* Wout_t = WSP(bf16, WS_WOUT); bf16* Wrt = WSP(bf16, WS_WRT);
    unsigned char* Wup_t = WSP(unsigned char, WS_WUP); bf16* H1 = WSP(bf16, WS_H1);
    if (F.wave < 4) for (int itv = F.vcu * 4 + F.wave; itv < 16 * 64; itv += F.G * 4) {
        const int it = __builtin_amdgcn_readfirstlane(itv);
        const int nb = it & 15, k8 = it >> 4, n = nb * 64 + lane, k0 = k8 * 8, g = k0 >> 7, kk0 = k0 & 127;
        const float* pw = F.pool_w + ((size_t)g * 128 + kk0) * 128; const float* ps = F.pool_scale + g * 128;
        f32x4 pv[4];
#pragma unroll
        for (int t = 0; t < 4; ++t) pv[t] = *(const GAS f32x4*)(pw + (t * 64 + lane) * 4);
        const f32x4 sv = *(const GAS f32x4*)(ps + (lane & 31) * 4);
        const float* wpu = F.w_pool_proj + (size_t)(g * 128) * DM + nb * 64;
        float b0[16], b1[16];
#pragma unroll
        for (int j = 0; j < 16; ++j) b0[j] = wpu[(size_t)j * DM + lane];
#pragma unroll
        for (int t = 0; t < 4; ++t) *(LAS f32x4*)(scr + (t * 64 + lane) * 4) = pv[t] * sv;
        LDS_WAIT(); asm volatile("" ::: "memory");
        float a[8];
#pragma unroll
        for (int i = 0; i < 8; ++i) a[i] = 0.f;
#define FOLD_FMA(BC, c) do { _Pragma("unroll") for (int j0 = 0; j0 < 16; j0 += 4) _Pragma("unroll") for (int i = 0; i < 8; ++i) { const f32x4 qq = *(const LAS f32x4*)(scr + i * 128 + (c) * 16 + j0); \
                a[i] += (qq.x * BC[j0] + qq.y * BC[j0 + 1]) + (qq.z * BC[j0 + 2] + qq.w * BC[j0 + 3]); } } while (0)
#pragma unroll 1
        for (int c = 0; c < 8; c += 2) {
            const float* w1 = wpu + (size_t)((c + 1) * 16) * DM;
#pragma unroll
            for (int j = 0; j < 16; ++j) b1[j] = w1[(size_t)j * DM + lane];
            FOLD_FMA(b0, c);
            asm volatile("" ::: "memory");
            if (c + 2 < 8) { const float* w2 = wpu + (size_t)((c + 2) * 16) * DM;
#pragma unroll
                for (int j = 0; j < 16; ++j) b0[j] = w2[(size_t)j * DM + lane]; }
            FOLD_FMA(b1, c + 1);
            asm volatile("" ::: "memory");
        }
#undef FOLD_FMA
        LDS_WAIT(); asm volatile("" ::: "memory");
        v4u o; o.x = pk2(a[0], a[1]); o.y = pk2(a[2], a[3]); o.z = pk2(a[4], a[5]); o.w = pk2(a[6], a[7]);
        *(GAS v4u*)(Wmix_t + (size_t)n * DM + k0) = o;
    }
    constexpr int I_IN = (DM / 64) * 24  , I_OUT = (DM / 64) * (DM / 32), I_AP = (512 / 64) * (DM / 32);
    constexpr int NITEMS = I_IN + I_OUT + I_AP;
    for (int it = gw; it < NITEMS; it += NGW) {
        int r = it;
        if (r < I_IN) { p0_transpose_item<0>(F.w_in, INW, Win_t, DM, 0, scr, r, lane, 24, 16, 16); continue; } r -= I_IN;
        if (r < I_OUT) { p0_transpose_item<0>(F.w_out, DM, Wout_t, DM, 0, scr, r, lane); continue; } r -= I_OUT;
        p0_transpose_item<0>(F.w_attn_proj, DM, Wmix_t, DM, 512, scr, r, lane);
    }
    {
        const GAS f32x4* gp = (const GAS f32x4*)F.norm1_g + lane; f32x4 g[4];
#pragma unroll
        for (int j = 0; j < 4; ++j) g[j] = gp[64 * j];
        constexpr int RB = 4;
        for (int m0 = gw * RB; m0 < T_TOK; m0 += NGW * RB) {
            f32x4 v[RB][4];
#pragma unroll
            for (int q = 0; q < RB; ++q) { const GAS f32x4* xr = (const GAS f32x4*)(F.x + (size_t)(m0 + q) * DM) + lane;
#pragma unroll
                for (int j = 0; j < 4; ++j) v[q][j] = __builtin_nontemporal_load(xr + 64 * j); }
#pragma unroll
            for (int q = 0; q < RB; ++q) { float s2 = 0.f;
#pragma unroll
                for (int j = 0; j < 4; ++j) s2 += (v[q][j].x * v[q][j].x + v[q][j].y * v[q][j].y) + (v[q][j].z * v[q][j].z + v[q][j].w * v[q][j].w);
                const float rstd = 1.f / sqrtf(wave_sum(s2) * (1.f / DM) + RMS_EPS);
                GAS unsigned long long* o8 = (GAS unsigned long long*)(H1 + (size_t)(m0 + q) * DM) + lane; GAS unsigned* o4 = (GAS unsigned*)(WSP(unsigned char, WS_H18) + (size_t)(m0 + q) * DM) + lane;
#pragma unroll
                for (int j = 0; j < 4; ++j) { const float h0 = v[q][j].x * rstd * g[j].x, h1v = v[q][j].y * rstd * g[j].y, h2 = v[q][j].z * rstd * g[j].z, h3 = v[q][j].w * rstd * g[j].w;
                    o8[64 * j] = (unsigned long long)pk2(h0, h1v) | ((unsigned long long)pk2(h2, h3) << 32); o4[64 * j] = pk4_fp8(h0, h1v, h2, h3); } }
        }
    }
    convert_win8(F);
    for (int it = gw * 64 + lane; it < 32 * 128; it += NGW * 64) {
        const int e = it & 31, k0 = (it >> 5) * 8; unsigned hi[4], lo[4];
#pragma unroll
        for (int i = 0; i < 4; ++i) { const float v0 = F.w_router[(size_t)(k0 + 2 * i) * NEXP + e] * F.norm2_g[k0 + 2 * i], v1 = F.w_router[(size_t)(k0 + 2 * i + 1) * NEXP + e] * F.norm2_g[k0 + 2 * i + 1];
            hi[i] = pk2(v0, v1); lo[i] = pk2(v0 - bf_lo(hi[i]), v1 - bf_hi(hi[i])); }
        *(GAS v4u*)(Wrt + (size_t)e * DM + k0) = (v4u){hi[0], hi[1], hi[2], hi[3]};
        *(GAS v4u*)(Wrt + (size_t)(NEXP + e) * DM + k0) = (v4u){lo[0], lo[1], lo[2], lo[3]};
    }
}

struct ProbDense {
    static constexpr bool GATHER = false, FP8 = false;
    const char* A; const char* Bt;
    __device__ __forceinline__ const char* a_tile(const pg8::Unit& u) const { return A + (size_t)u.pm * (256 * 2048); }
    __device__ __forceinline__ const char* b_tile(const pg8::Unit& u) const { return Bt + (size_t)u.pn * (256 * 2048); }
    __device__ __forceinline__ unsigned a_rowoff(const pg8::Unit&, int) const { return 0u; }
};
struct ProbDense8 {
    static constexpr bool GATHER = false, FP8 = true;
    const char* A; const char* Bt;
    __device__ __forceinline__ const char* a_tile(const pg8::Unit& u) const { return A + (size_t)u.pm * (256 * 1024); }
    __device__ __forceinline__ const char* b_tile(const pg8::Unit& u) const { return Bt + (size_t)u.pn * (256 * 1024); }
    __device__ __forceinline__ unsigned a_rowoff(const pg8::Unit&, int) const { return 0u; }
};
struct StaticOrderPn2 : pg8::StaticOrder {
    __host__ __device__ bool next(int i, pg8::Unit& u) const { if (!pg8::StaticOrder::next(i, u)) return false; if (u.pn == 2) u.pn = 4; return true; }
};
struct P1Order {
    static constexpr bool WAITS = false, PUBLISHES = false;
    int x, r, fp8;
    __host__ __device__ bool next(int i, pg8::Unit& u) const {
        int j;
        if (!fp8) { if (i != 0 || r >= 24) return false; j = r < 16 ? r : 16 + r; }
        else { if (r < 24) { if (i > 1) return false; j = r + 24 * i; } else { if (i > 3) return false; j = 48 + (r - 24) + 8 * i; } }
        u.pm = 8 * x + (j & 7); u.pn = j >> 3; return true;
    }
};
struct ProbUp {
    static constexpr bool GATHER = true, FP8 = true;
    const char* A; const char* Bt; const int* ltok; const LAS int* TAB;
    __device__ __forceinline__ const char* a_tile(const pg8::Unit&) const { return A; }
    __device__ __forceinline__ const char* b_tile(const pg8::Unit& u) const { const int e = __builtin_amdgcn_readfirstlane(TAB[72 + u.pm]); return Bt + ((size_t)e * 2048 + (size_t)u.pn * 256) * 1024; }
    static constexpr unsigned GMAX = T_TOK - 1;
    __device__ __forceinline__ const char* gather_src(const pg8::Unit& u) const {
        const int e = __builtin_amdgcn_readfirstlane(TAB[72 + u.pm]), pos0 = (u.pm - __builtin_amdgcn_readfirstlane(TAB[32 + e])) * 256;
        return (const char*)(ltok + e * CAP + pos0); }
    __device__ __forceinline__ unsigned a_rowoff(const pg8::Unit&, int) const { return 0u; }
};
struct ProbDown {
    static constexpr bool GATHER = false, FP8 = true;
    const char* A; const char* Bt; const LAS int* TAB;
    __device__ __forceinline__ const char* a_tile(const pg8::Unit& u) const { return A + (size_t)u.pm * (256 * 1024); }
    __device__ __forceinline__ const char* b_tile(const pg8::Unit& u) const { const int e = __builtin_amdgcn_readfirstlane(TAB[72 + u.pm]); return Bt + ((size_t)e * 1024 + (size_t)u.pn * 256) * 1024; }
    __device__ __forceinline__ unsigned a_rowoff(const pg8::Unit&, int) const { return 0u; }
};

using pg8::f32x2; using pg8::u32x4;
struct NoPre {};
struct EpiInProj {
    static constexpr bool PERM = true, PREFETCH = false; static constexpr int MID = 0; typedef NoPre Pre;
    bf16 *U, *Q, *KV, *GP, *GA;
    __device__ __forceinline__ void mid(pg8::f32x4 (&)[2][2][4][2], const pg8::Unit&, int, int, int, int) const {}
    __device__ __forceinline__ void operator()(const pg8::f32x4 (&acc)[2][2][4][2], const NoPre&, const pg8::Unit& u, int wr, int wc, int fr, int fq) const {
        bf16* base; int ldc; float sc = 1.f; const int pn = u.pn;
        if (pn < 2) { base = U + pn * 256; ldc = 512; } else if (pn < 4) { base = Q + (pn - 2) * 256; ldc = 512; sc = 0.125f; } else if (pn == 4) { base = KV; ldc = 256; }
        else if (pn < 9) { base = GP + (pn - 5) * 256; ldc = 1024; } else { base = GA + (pn - 9) * 256; ldc = 1024; }
        const int row0 = u.pm * 256 + wr * 64 + fr, col0 = wc * 32 + 8 * fq;
#pragma unroll
        for (int ai = 0; ai < 2; ++ai)
#pragma unroll
            for (int m = 0; m < 4; ++m) { bf16* rowp = base + (size_t)(row0 + ai * 128 + m * 16) * ldc + col0;
#pragma unroll
                for (int bj = 0; bj < 2; ++bj) { const pg8::f32x4 v0 = acc[ai][bj][m][0] * sc, v1 = acc[ai][bj][m][1] * sc;
                    u32x4 w; w.x = cvt_pk_bf16(v0[0], v0[1]); w.y = cvt_pk_bf16(v0[2], v0[3]); w.z = cvt_pk_bf16(v1[0], v1[1]); w.w = cvt_pk_bf16(v1[2], v1[3]);
                    *(u32x4*)(rowp + bj * 128) = w; } }
    }
};
struct EpiGate8 {
    static constexpr bool PERM = true, PREFETCH = false; static constexpr int MID = 0; typedef NoPre Pre;
    unsigned char *GP, *GA; bf16* Q;
    __device__ __forceinline__ void mid(pg8::f32x4 (&)[2][2][4][2], const pg8::Unit&, int, int, int, int) const {}
    __device__ __forceinline__ void operator()(const pg8::f32x4 (&acc)[2][2][4][2], const NoPre&, const pg8::Unit& u, int wr, int wc, int fr, int fq) const {
        const int row0 = u.pm * 256 + wr * 64 + fr, col0 = wc * 32 + 8 * fq;
        if (u.pn >= 8) {
            bf16* ub = Q + (u.pn - 8) * 256;
#pragma unroll
            for (int ai = 0; ai < 2; ++ai)
#pragma unroll
                for (int m = 0; m < 4; ++m) { bf16* rowp = ub + (size_t)(row0 + ai * 128 + m * 16) * 512 + col0;
#pragma unroll
                    for (int bj = 0; bj < 2; ++bj) { const pg8::f32x4 v0 = acc[ai][bj][m][0] * (W8_INV * 0.125f), v1 = acc[ai][bj][m][1] * (W8_INV * 0.125f);
                        u32x4 w; w.x = cvt_pk_bf16(v0[0], v0[1]); w.y = cvt_pk_bf16(v0[2], v0[3]); w.z = cvt_pk_bf16(v1[0], v1[1]); w.w = cvt_pk_bf16(v1[2], v1[3]);
                        *(u32x4*)(rowp + bj * 128) = w; } }
            return;
        }
        unsigned char* base = (u.pn < 4) ? GP + u.pn * 256 : GA + (u.pn - 4) * 256;
#pragma unroll
        for (int ai = 0; ai < 2; ++ai)
#pragma unroll
            for (int m = 0; m < 4; ++m) { unsigned char* rowp = base + (size_t)(row0 + ai * 128 + m * 16) * 1024 + col0;
#pragma unroll
                for (int bj = 0; bj < 2; ++bj) { const pg8::f32x4 v0 = acc[ai][bj][m][0] * W8_INV, v1 = acc[ai][bj][m][1] * W8_INV;
                    v2u w; w.x = pk4_fp8(v0[0], v0[1], v0[2], v0[3]); w.y = pk4_fp8(v1[0], v1[1], v1[2], v1[3]);
                    *(v2u*)(rowp + bj * 128) = w; } }
    }
};
__device__ __forceinline__ float clampf(float x, float lo, float hi) { return fminf(fmaxf(x, lo), hi); }
__device__ __forceinline__ float en(float x) { return __builtin_amdgcn_exp2f(-LOG2E * clampf(x, -80.f, 80.f)); }
struct EpiMix {
    static constexpr bool PERM = true, PREFETCH = false; static constexpr int MID = 8; typedef NoPre Pre;
    const unsigned char *GP, *GA; bf16* MIX;
    static __device__ __forceinline__ void dec8(v2u w, float (&x)[8]) {
        const f32x2_t a = __builtin_amdgcn_cvt_pk_f32_fp8((int)w.x, false), b = __builtin_amdgcn_cvt_pk_f32_fp8((int)w.x, true), c = __builtin_amdgcn_cvt_pk_f32_fp8((int)w.y, false), d = __builtin_amdgcn_cvt_pk_f32_fp8((int)w.y, true);
        x[0] = a[0]; x[1] = a[1]; x[2] = b[0]; x[3] = b[1]; x[4] = c[0]; x[5] = c[1]; x[6] = d[0]; x[7] = d[1]; }
    __device__ __forceinline__ void mid(pg8::f32x4 (&acc)[2][2][4][2], const pg8::Unit& u, int wr, int wc, int fr, int fq) const {
        const unsigned off0 = (unsigned)(u.pm * 256 + wr * 64 + fr) * 1024u + (unsigned)(u.pn * 256 + wc * 32 + 8 * fq);
#pragma unroll
        for (int ai = 0; ai < 2; ++ai) {
            v2u p[4][2], a[4][2];
#pragma unroll
            for (int m = 0; m < 4; ++m)
#pragma unroll
                for (int bj = 0; bj < 2; ++bj) { const unsigned off = off0 + (unsigned)((ai * 128 + m * 16) * 1024 + bj * 128); p[m][bj] = *(const v2u*)(GP + off); a[m][bj] = *(const v2u*)(GA + off); }
#pragma unroll
            for (int m = 0; m < 4; ++m)
#pragma unroll
                for (int bj = 0; bj < 2; ++bj) { float xp[8], xa[8]; dec8(p[m][bj], xp); dec8(a[m][bj], xa);
#pragma unroll
                    for (int c = 0; c < 8; ++c) acc[ai][bj][m][c >> 2][c & 3] *= (1.f + en(xa[c])) * __builtin_amdgcn_rcpf(1.f + en(xp[c]));
                    asm volatile("" : "+v"(acc[ai][bj][m][0]), "+v"(acc[ai][bj][m][1])); }
            asm volatile("" ::: "memory");
        }
    }
    __device__ __forceinline__ void operator()(const pg8::f32x4 (&acc)[2][2][4][2], const NoPre&, const pg8::Unit& u, int wr, int wc, int fr, int fq) const {
        const unsigned off0 = (unsigned)(u.pm * 256 + wr * 64 + fr) * 1024u + (unsigned)(u.pn * 256 + wc * 32 + 8 * fq);
        v2u a[2][4][2];
#pragma unroll
        for (int ai = 0; ai < 2; ++ai)
#pragma unroll
            for (int m = 0; m < 4; ++m)
#pragma unroll
                for (int bj = 0; bj < 2; ++bj) a[ai][m][bj] = *(const v2u*)(GA + off0 + (unsigned)((ai * 128 + m * 16) * 1024 + bj * 128));
#pragma unroll
        for (int ai = 0; ai < 2; ++ai)
#pragma unroll
            for (int m = 0; m < 4; ++m)
#pragma unroll
                for (int bj = 0; bj < 2; ++bj) { float xa[8], sg[8]; dec8(a[ai][m][bj], xa);
#pragma unroll
                    for (int c = 0; c < 8; ++c) sg[c] = __builtin_amdgcn_rcpf(1.f + en(xa[c]));
                    const pg8::f32x4 v0 = acc[ai][bj][m][0], v1 = acc[ai][bj][m][1];
                    u32x4 w; w.x = cvtpk_s(v0[0] * sg[0], v0[1] * sg[1]); w.y = cvtpk_s(v0[2] * sg[2], v0[3] * sg[3]); w.z = cvtpk_s(v1[0] * sg[4], v1[1] * sg[5]); w.w = cvtpk_s(v1[2] * sg[6], v1[3] * sg[7]);
                    *(u32x4*)(MIX + off0 + (unsigned)((ai * 128 + m * 16) * 1024 + bj * 128)) = w; }
    }
};
struct EpiOut {
    static constexpr bool PERM = true, PREFETCH = false; static constexpr int MID = 0; typedef NoPre Pre;
    const float* X; bf16* X1;
    __device__ __forceinline__ void mid(pg8::f32x4 (&)[2][2][4][2], const pg8::Unit&, int, int, int, int) const {}
    __device__ __forceinline__ void operator()(const pg8::f32x4 (&acc)[2][2][4][2], const NoPre&, const pg8::Unit& u, int wr, int wc, int fr, int fq) const {
        const unsigned off0 = (unsigned)(u.pm * 256 + wr * 64 + fr) * 1024u + (unsigned)(u.pn * 256 + wc * 32 + 8 * fq);
        auto ldx = [&](int ai, int m, pg8::f32x4 (&xv)[2][2]) {
#pragma unroll
            for (int bj = 0; bj < 2; ++bj)
#pragma unroll
                for (int n = 0; n < 2; ++n) xv[bj][n] = *(const pg8::f32x4*)(X + off0 + (unsigned)((ai * 128 + m * 16) * 1024 + bj * 128 + n * 4)); };
        auto stx = [&](int ai, int m, const pg8::f32x4 (&xv)[2][2]) {
#pragma unroll
            for (int bj = 0; bj < 2; ++bj) { const pg8::f32x4 v0 = xv[bj][0] + acc[ai][bj][m][0], v1 = xv[bj][1] + acc[ai][bj][m][1];
                u32x4 w; w.x = cvtpk_s(v0[0], v0[1]); w.y = cvtpk_s(v0[2], v0[3]); w.z = cvtpk_s(v1[0], v1[1]); w.w = cvtpk_s(v1[2], v1[3]);
                *(u32x4*)(X1 + off0 + (unsigned)((ai * 128 + m * 16) * 1024 + bj * 128)) = w; } };
        pg8::f32x4 xa[4][2][2], xb[2][2][2];
#pragma unroll
        for (int m = 0; m < 4; ++m) ldx(0, m, xa[m]);
#pragma unroll
        for (int m = 0; m < 2; ++m) ldx(1, m, xb[m]);
#pragma unroll
        for (int m = 0; m < 2; ++m) stx(0, m, xa[m]);
        asm volatile("" ::: "memory");
#pragma unroll
        for (int m = 0; m < 2; ++m) ldx(1, 2 + m, xa[m]);
#pragma unroll
        for (int m = 2; m < 4; ++m) stx(0, m, xa[m]);
#pragma unroll
        for (int m = 0; m < 2; ++m) stx(1, m, xb[m]);
        asm volatile("" ::: "memory");
#pragma unroll
        for (int m = 0; m < 2; ++m) stx(1, 2 + m, xa[m]);
    }
};
struct EpiUp {
    static constexpr bool PERM = true, PREFETCH = true; static constexpr int MID = 0;
    struct Pre { int slot; };
    const float* b_up; const float* lrstd; unsigned char* ACT; const LAS int* TAB; const LAS unsigned char* lds;
    __device__ __forceinline__ void stage(Pre& p, const pg8::Unit& u, int ui, int wid, int lane, unsigned lds0) const {
        const int e = __builtin_amdgcn_readfirstlane(TAB[72 + u.pm]), pos0 = (u.pm - __builtin_amdgcn_readfirstlane(TAB[32 + e])) * 256;
        p.slot = ui & 1; const unsigned dst = lds0 + (unsigned)pg8::EPS_OFF + (unsigned)(p.slot * 2048);
        if (wid == 1) pg8::glds16s((const char*)(b_up + (size_t)e * 2048 + 256 * u.pn), (unsigned)lane * 16u, dst);
        if (wid == 2) pg8::glds16s((const char*)(lrstd + e * CAP + pos0), (unsigned)lane * 16u, dst + 1024u);
    }
    __device__ __forceinline__ void mid(pg8::f32x4 (&)[2][2][4][2], const pg8::Unit&, int, int, int, int) const {}
    __device__ __forceinline__ void operator()(const pg8::f32x4 (&acc)[2][2][4][2], const Pre& pre, const pg8::Unit& u, int wr, int wc, int fr, int fq) const {
        const int e = __builtin_amdgcn_readfirstlane(TAB[72 + u.pm]), pos0 = (u.pm - __builtin_amdgcn_readfirstlane(TAB[32 + e])) * 256, cnt = __builtin_amdgcn_readfirstlane(TAB[e]);
        const int rl0 = wr * 64 + fr, cc0 = wc * 32 + 8 * fq;
        const LAS unsigned char* side = lds + pg8::EPS_OFF + pre.slot * 2048;
        pg8::f32x4 bq[4]; float rsv[2][4];
#pragma unroll
        for (int q = 0; q < 4; ++q) bq[q] = *(const LAS pg8::f32x4*)(side + (2 * cc0 + 4 * q) * 4);
#pragma unroll
        for (int ai = 0; ai < 2; ++ai)
#pragma unroll
            for (int m = 0; m < 4; ++m) { const int rl_ = rl0 + ai * 128 + m * 16; const float rv = *(const LAS float*)(side + 1024 + rl_ * 4); rsv[ai][m] = (pos0 + rl_) < cnt ? rv * W8_INV : 0.f; }
        f32x2 bg[4], bl[4];
#pragma unroll
        for (int q = 0; q < 4; ++q) { bg[q] = (f32x2){bq[q][0], bq[q][2]}; bl[q] = (f32x2){bq[q][1], bq[q][3]}; }
        constexpr float KS = -1.702f * LOG2E;
#pragma unroll
        for (int ai = 0; ai < 2; ++ai)
#pragma unroll
            for (int m = 0; m < 4; ++m) { const int rl = rl0 + ai * 128 + m * 16; const float rs = rsv[ai][m]; const f32x2 rs2 = (f32x2){rs, rs};
                unsigned pk[4];
#pragma unroll
                for (int p = 0; p < 4; ++p) { const int n = p >> 1, i = (p & 1) * 2;
                    f32x2 g = (f32x2){acc[ai][0][m][n][i], acc[ai][0][m][n][i + 1]} * rs2 + bg[p], l = (f32x2){acc[ai][1][m][n][i], acc[ai][1][m][n][i + 1]} * rs2 + bl[p];
                    g.x = fminf(g.x, 7.0f); g.y = fminf(g.y, 7.0f); l.x = __builtin_amdgcn_fmed3f(l.x, -7.0f, 7.0f); l.y = __builtin_amdgcn_fmed3f(l.y, -7.0f, 7.0f);
                    const f32x2 t = g * KS; f32x2 ex; ex.x = __builtin_amdgcn_exp2f(t.x); ex.y = __builtin_amdgcn_exp2f(t.y);
                    const f32x2 d = ex + 1.0f; f32x2 sg; sg.x = __builtin_amdgcn_rcpf(d.x); sg.y = __builtin_amdgcn_rcpf(d.y);
                    const f32x2 o = g * sg, r = o * l + o;
                    pk[p] = (unsigned)__builtin_amdgcn_cvt_pk_fp8_f32(r.x, r.y, 0, false) & 0xffffu; }
                v2u w; w.x = pk[0] | (pk[1] << 16); w.y = pk[2] | (pk[3] << 16);
                *(v2u*)(ACT + (size_t)(u.pm * 256 + rl) * 1024 + 128 * u.pn + cc0) = w; }
    }
};
struct EpiDown {
    static constexpr bool PERM = true, PREFETCH = true; static constexpr int MID = 0;
    struct Pre { int slot; };
    const float* b_dn; const float* lgate; unsigned char* Y; const LAS int* TAB; const LAS unsigned char* lds;
    __device__ __forceinline__ void stage(Pre& p, const pg8::Unit& u, int ui, int wid, int lane, unsigned lds0) const {
        const int e = __builtin_amdgcn_readfirstlane(TAB[72 + u.pm]), pos0 = (u.pm - __builtin_amdgcn_readfirstlane(TAB[32 + e])) * 256;
        p.slot = ui & 1; const unsigned dst = lds0 + (unsigned)pg8::EPS_OFF + (unsigned)(p.slot * 2048);
        if (wid == 1) pg8::glds16s((const char*)(b_dn + (size_t)e * 1024 + 256 * u.pn), (unsigned)lane * 16u, dst);
        if (wid == 2) pg8::glds16s((const char*)(lgate + e * CAP + pos0), (unsigned)lane * 16u, dst + 1024u);
    }
    __device__ __forceinline__ void mid(pg8::f32x4 (&)[2][2][4][2], const pg8::Unit&, int, int, int, int) const {}
    __device__ __forceinline__ void operator()(const pg8::f32x4 (&acc)[2][2][4][2], const Pre& pre, const pg8::Unit& u, int wr, int wc, int fr, int fq) const {
        const int e = __builtin_amdgcn_readfirstlane(TAB[72 + u.pm]), pos0 = (u.pm - __builtin_amdgcn_readfirstlane(TAB[32 + e])) * 256, cnt = __builtin_amdgcn_readfirstlane(TAB[e]);
        const int rl0 = wr * 64 + fr, col0 = u.pn * 256 + wc * 32 + 8 * fq;
        const LAS unsigned char* side = lds + pg8::EPS_OFF + pre.slot * 2048; const int lc0 = wc * 32 + 8 * fq;
        pg8::f32x4 bv[2][2]; float gtv[2][4];
#pragma unroll
        for (int bj = 0; bj < 2; ++bj)
#pragma unroll
            for (int n = 0; n < 2; ++n) bv[bj][n] = *(const LAS pg8::f32x4*)(side + (lc0 + bj * 128 + 4 * n) * 4);
#pragma unroll
        for (int ai = 0; ai < 2; ++ai)
#pragma unroll
            for (int m = 0; m < 4; ++m) { const int rl_ = rl0 + ai * 128 + m * 16; const float gv = *(const LAS float*)(side + 1024 + rl_ * 4); gtv[ai][m] = (pos0 + rl_) < cnt ? gv : 0.f; }
#pragma unroll
        for (int ai = 0; ai < 2; ++ai)
#pragma unroll
            for (int m = 0; m < 4; ++m) { const int rl = rl0 + ai * 128 + m * 16; const float gt = gtv[ai][m], gs = gt * W8_INV;
                unsigned char* rowp = Y + (size_t)(u.pm * 256 + rl) * 1024 + col0;
#pragma unroll
                for (int bj = 0; bj < 2; ++bj) { const pg8::f32x4 v0 = acc[ai][bj][m][0] * gs + bv[bj][0] * gt, v1 = acc[ai][bj][m][1] * gs + bv[bj][1] * gt;
                    v2u w; w.x = pk4_fp8(v0[0], v0[1], v0[2], v0[3]); w.y = pk4_fp8(v1[0], v1[1], v1[2], v1[3]);
                    *(v2u*)(rowp + bj * 128) = w; } }
    }
};

__device__ const unsigned char T5_BUCKET[128] = {0, 1, 2, 3, 4, 5, 6, 7, 8, 9, 10, 11, 12, 13, 14, 15, 16, 16, 16, 17, 17, 18, 18, 18, 19, 19, 19, 20, 20, 20, 20, 21, 21, 21, 21, 22, 22, 22, 22, 22, 23, 23, 23, 23, 23, 23, 24, 24, 24, 24, 24, 24, 25, 25, 25, 25, 25, 25, 25, 26, 26, 26, 26, 26, 26, 26, 26, 27, 27, 27, 27, 27, 27, 27, 27, 27, 27, 28, 28, 28, 28, 28, 28, 28, 28, 28, 28, 29, 29, 29, 29, 29, 29, 29, 29, 29, 29, 29, 29, 30, 30, 30, 30, 30, 30, 30, 30, 30, 30, 30, 30, 30, 30, 31, 31, 31, 31, 31, 31, 31, 31, 31, 31, 31, 31, 31, 31, 31};
constexpr int KS_PITCH = 144, VT_PITCH = 520;
constexpr int ATT_KS = 0, ATT_VT = 256 * KS_PITCH, ATT_BIAS = ATT_VT + 64 * VT_PITCH;
constexpr int ATT_BTN = 200;
static_assert(ATT_BIAS % 16 == 0 && ATT_BIAS + 16 * ATT_BTN * 4 <= RING_BYTES, "attention LDS");
__device__ __forceinline__ int crow(int i, int hi) { return (i & 3) + 8 * (i >> 2) + 4 * hi; }
__device__ __forceinline__ void attn_unit(Frame& F, int b, int nblk, int kvh) {
    const bf16* Q = WSP(bf16, WS_Q); const bf16* KV = WSP(bf16, WS_KV); bf16* ZA = WSP(bf16, WS_ZA);
    LAS unsigned char* ks = F.lds + RING_OFF + ATT_KS; LAS unsigned char* vt = F.lds + RING_OFF + ATT_VT; LAS float* bias2 = (LAS float*)(F.lds + RING_OFF + ATT_BIAS);
    const int tid = F.tid, lane = F.lane, w = F.wave;
    const int kpos0 = (nblk - 1) * 128;
    bf16x8 qfa[2][4];
    { const int g_ = w >> 1, qh_ = kvh * 4 + g_, ql_ = lane & 31, hi_ = lane >> 5;
#pragma unroll
      for (int qt2 = 0; qt2 < 2; ++qt2) { const size_t tq_ = (size_t)b * SEQ + nblk * 128 + 32 * (2 * (w & 1) + qt2) + ql_;
#pragma unroll
          for (int s2 = 0; s2 < 4; ++s2) qfa[qt2][s2] = *(const GAS bf16x8*)(Q + tq_ * 512 + qh_ * 64 + s2 * 16 + hi_ * 8); } }
    __syncthreads();
#pragma unroll
    for (int i = 0; i < 2; ++i) {
        const int c = tid + 512 * i, rp = c >> 3, part = c & 7, row = 2 * rp; const int kp = kpos0 + row;
        v4u k0 = (v4u){0u, 0u, 0u, 0u}, v0 = k0, k1 = k0, v1 = k0;
        if (kp >= 0) { const bf16* src = KV + (size_t)(b * SEQ + kp) * 256 + kvh * 64 + part * 8; k0 = *(const GAS v4u*)src; v0 = *(const GAS v4u*)(src + 128); k1 = *(const GAS v4u*)(src + 256); v1 = *(const GAS v4u*)(src + 256 + 128); }
        *(LAS v4u*)(ks + row * KS_PITCH + part * 16) = k0; *(LAS v4u*)(ks + (row + 1) * KS_PITCH + part * 16) = k1;
        LAS unsigned* vd = (LAS unsigned*)(vt + (part * 8) * VT_PITCH + row * 2);
#pragma unroll
        for (int j = 0; j < 4; ++j) { vd[(2 * j) * (VT_PITCH / 4)] = (v0[j] & 0xffffu) | (v1[j] << 16); vd[(2 * j + 1) * (VT_PITCH / 4)] = (v0[j] >> 16) | (v1[j] & 0xffff0000u); }
    }
#pragma unroll
    for (int it = 0; it < 7; ++it) { const int e = tid + 512 * it; if (e < 16 * ATT_BTN) { const int g_ = e / (4 * ATT_BTN), rem = e % (4 * ATT_BTN), s_ = rem / ATT_BTN, j_ = rem % ATT_BTN, d = 127 - (j_ - 40 + s_);
            bias2[e] = (d >= 0 && d < 128) ? F.rel_bias[(int)T5_BUCKET[d] * 8 + kvh * 4 + g_] * LOG2E : -1e30f; } }
    __syncthreads();
    const int g = w >> 1, qh = kvh * 4 + g, ql = lane & 31, hi = lane >> 5;
    const float sink2 = F.sinks[qh] * LOG2E;
    const int sft = (3 - (ql & 3)) & 3;
    const LAS unsigned char* btab = (const LAS unsigned char*)bias2 + ((g * 4 + sft) * ATT_BTN + (39 - ql - sft + 4 * hi)) * 4;
#pragma unroll 1
    for (int qt2 = 0; qt2 < 2; ++qt2) {
        const int q0 = 32 * (2 * (w & 1) + qt2), qi = q0 + ql; const size_t tq = (size_t)b * SEQ + nblk * 128 + qi;
        bf16x8 qf[4];
#pragma unroll
        for (int s = 0; s < 4; ++s) qf[s] = qt2 ? qfa[1][s] : qfa[0][s];
        f32x16 sc[5];
#pragma unroll
        for (int kt = 0; kt < 5; ++kt) {
            f32x16 a;
#pragma unroll
            for (int i = 0; i < 16; ++i) a[i] = 0.f;
            const int kb = q0 + 32 * kt;
#pragma unroll
            for (int s = 0; s < 4; ++s) { const bf16x8 kf = *(const LAS bf16x8*)(ks + (kb + ql) * KS_PITCH + s * 32 + hi * 16); a = __builtin_amdgcn_mfma_f32_32x32x16_bf16(kf, qf[s], a, 0, 0, 0); }
            sc[kt] = a;
        }
        float mx = sink2;
        if (nblk != 0) {
#pragma unroll
            for (int kt = 0; kt < 5; ++kt)
#pragma unroll
                for (int r4 = 0; r4 < 4; ++r4) { const LAS float* bp_ = (const LAS float*)(btab + 128 * kt + 32 * r4);
#pragma unroll
                    for (int c = 0; c < 4; ++c) { const int i = 4 * r4 + c; const float s = sc[kt][i] * LOG2E + bp_[c]; sc[kt][i] = s; mx = fmaxf(mx, s); } }
        } else {
#pragma unroll
            for (int kt = 0; kt < 5; ++kt)
#pragma unroll
                for (int r4 = 0; r4 < 4; ++r4) { const LAS float* bp_ = (const LAS float*)(btab + 128 * kt + 32 * r4);
#pragma unroll
                    for (int c = 0; c < 4; ++c) { const int i = 4 * r4 + c; const int kj = q0 + 32 * kt + crow(i, hi);
                        const float s = (kj >= 128) ? sc[kt][i] * LOG2E + bp_[c] : -1e30f; sc[kt][i] = s; mx = fmaxf(mx, s); } }
        }
        mx = fmaxf(mx, __shfl_xor(mx, 32));
        float l = 0.f;
#pragma unroll
        for (int kt = 0; kt < 5; ++kt)
#pragma unroll
            for (int i = 0; i < 16; ++i) { const float p = __builtin_amdgcn_exp2f(sc[kt][i] - mx); sc[kt][i] = p; l += p; }
        l += __shfl_xor(l, 32); l += __builtin_amdgcn_exp2f(sink2 - mx);
        const float inv = 1.f / l;
        f32x16 o[2];
#pragma unroll
        for (int dt = 0; dt < 2; ++dt)
#pragma unroll
            for (int i = 0; i < 16; ++i) o[dt][i] = 0.f;
#pragma unroll
        for (int kt = 0; kt < 5; ++kt)
#pragma unroll
            for (int ss = 0; ss < 2; ++ss) {
                v4u pw;
#pragma unroll
                for (int j = 0; j < 4; ++j) pw[j] = cvt_pk_bf16(sc[kt][8 * ss + 2 * j], sc[kt][8 * ss + 2 * j + 1]);
                const bf16x8 pf = __builtin_bit_cast(bf16x8, pw);
                const int kv0 = q0 + 32 * kt + 16 * ss + 4 * hi;
#pragma unroll
                for (int dt = 0; dt < 2; ++dt) { const LAS unsigned char* vp = vt + (dt * 32 + ql) * VT_PITCH + kv0 * 2;
                    const v2u v0 = *(const LAS v2u*)vp, v1 = *(const LAS v2u*)(vp + 16); const v4u vw = (v4u){v0.x, v0.y, v1.x, v1.y};
                    o[dt] = __builtin_amdgcn_mfma_f32_32x32x16_bf16(__builtin_bit_cast(bf16x8, vw), pf, o[dt], 0, 0, 0); }
            }
        bf16* orow = ZA + tq * 1024 + 512 + qh * 64;
#pragma unroll
        for (int dt = 0; dt < 2; ++dt)
#pragma unroll
            for (int q4 = 0; q4 < 4; ++q4) { v2u ww; ww.x = cvt_pk_bf16(o[dt][4 * q4] * inv, o[dt][4 * q4 + 1] * inv); ww.y = cvt_pk_bf16(o[dt][4 * q4 + 2] * inv, o[dt][4 * q4 + 3] * inv);
                *(GAS v2u*)(orow + dt * 32 + 8 * q4 + 4 * hi) = ww; }
    }
}
__device__ __forceinline__ void p2_attn_pool(Frame& F) {
    for (int uidx = F.vcu; uidx < NB * 32 * 2; uidx += F.G) { const int kvh = uidx & 1, nblk = (uidx >> 1) & 31, b = uidx >> 6; attn_unit(F, b, nblk, kvh); }
    const bf16* U = WSP(bf16, WS_U); bf16* ZA = WSP(bf16, WS_ZA);
    for (int it = F.vcu * NWAVES + F.wave; it < T_TOK / 8; it += F.G * NWAVES) {
        const int t0 = it * 8, c8 = F.lane, g = c8 >> 4, wnd = 2 << g, pos0 = t0 & (SEQ - 1);
        const bf16* up = U + (size_t)t0 * 512 + c8 * 8;
        v4u ur[23];
#pragma unroll
        for (int j = 0; j < 23; ++j) { const int rel = j - 15; ur[j] = (v4u){0u, 0u, 0u, 0u}; if (rel > -wnd && pos0 + rel >= 0) ur[j] = *(const GAS v4u*)(up + (ptrdiff_t)rel * 512); }
        float S[8];
#pragma unroll
        for (int c = 0; c < 8; ++c) S[c] = 0.f;
#pragma unroll
        for (int j = 0; j < 16; ++j)
#pragma unroll
            for (int q = 0; q < 4; ++q) { S[2 * q] += bf_lo(ur[j][q]); S[2 * q + 1] += bf_hi(ur[j][q]); }
#pragma unroll
        for (int i = 0; i < 8; ++i) {
            const int pos = pos0 + i, cnt = (pos + 1) < wnd ? (pos + 1) : wnd;
            if (i > 0) {
#pragma unroll
                for (int q = 0; q < 4; ++q) { const unsigned sb = g == 0 ? ur[13 + i][q] : (g == 1 ? ur[11 + i][q] : (g == 2 ? ur[7 + i][q] : ur[i - 1][q]));
                    S[2 * q] += bf_lo(ur[15 + i][q]) - bf_lo(sb); S[2 * q + 1] += bf_hi(ur[15 + i][q]) - bf_hi(sb); } }
            const float ic = 1.0f / (float)cnt; v4u o;
#pragma unroll
            for (int q = 0; q < 4; ++q) o[q] = cvtpk_s(S[2 * q] * ic - bf_lo(ur[15 + i][q]), S[2 * q + 1] * ic - bf_hi(ur[15 + i][q]));
            *(GAS v4u*)(ZA + (size_t)(t0 + i) * 1024 + c8 * 8) = o;
        }
    }
}

constexpr int P5_OFF = 133120;
static_assert(pg8::GIX_OFF == P5_OFF, "the gathered GEMM's index slots reuse the router's scratch");
static_assert(P5_OFF >= TAB_OFF + (32 + 40 + NRT_MAX) * 4 && P5_OFF + 4 * 2304 + 256 <= LDS_BYTES, "router scratch");
__device__ __forceinline__ void p5_router(Frame& F) {
    const bf16* X1 = WSP(bf16, WS_X1); unsigned char* H2 = WSP(unsigned char, WS_H2); const char* Wg = (const char*)WSP(bf16, WS_WRT);
    int* ltok = WSP(int, WS_LTOK); float* lgate = WSP(float, WS_LGATE); float* lrstd = WSP(float, WS_LRSTD); int* toke = WSP(int, WS_TOKE); int* tokp = WSP(int, WS_TOKP);
    int lane = F.lane; asm volatile("" : "+v"(lane));
    const int w = F.wave, r = lane & 15, q = lane >> 4, rg = w;
    LAS float* lg = (LAS float*)(F.lds + P5_OFF + (rg & 3) * 2304);
    LAS int* lcnt = (LAS int*)(F.lds + P5_OFF + 4 * 2304); LAS int* lbase = lcnt + 32;
    const LAS unsigned char* wl = F.lds + RING_OFF;
    const unsigned lds0 = (unsigned)(uintptr_t)(F.lds + RING_OFF);
    for (int tb = F.vcu; tb < T_TOK / 64; tb += F.G) {
        __syncthreads();
        if (F.tid < 32) lcnt[F.tid] = 0;
        int pe[4] = {0, 0, 0, 0}, pl[4] = {0, 0, 0, 0}; float pw[4] = {0.f, 0.f, 0.f, 0.f}; float rstd = 0.f;
        const int row0 = tb * 64 + (rg & 3) * 16;
        bf16x8 xr[32];
        if (w < 4) { const bf16* xp = X1 + (size_t)(row0 + r) * 1024 + 8 * q;
#pragma unroll
            for (int s2 = 0; s2 < 32; ++s2) xr[s2] = *(const GAS bf16x8*)(xp + 32 * s2); }
#pragma unroll
        for (int j = 0; j < 16; ++j) { const int p = w * 16 + j, R = p >> 1, cd = (p & 1) * 64 + lane;
            pg8::glds16s(Wg, (unsigned)(R * 2048 + ((cd ^ ((R & 3) << 2)) << 4)), lds0 + (unsigned)p * 1024u); }
        asm volatile("s_waitcnt vmcnt(0)" ::: "memory");
        __syncthreads();
        if (w < 4) {
            pg8::f32x4 a0 = (pg8::f32x4){0.f, 0.f, 0.f, 0.f}, a1 = a0; float ss = 0.f;
            unsigned char* hp = H2 + (size_t)(row0 + r) * 1024 + 8 * q;
            const LAS unsigned char* wb = wl + r * 2048; const int sw = (r & 3) << 2;
#pragma unroll
            for (int s2 = 0; s2 < 32; ++s2) {
                const v4u xw = __builtin_bit_cast(v4u, xr[s2]);
                const pg8::f32x4 xa = (pg8::f32x4){bf_lo(xw[0]), bf_hi(xw[0]), bf_lo(xw[1]), bf_hi(xw[1])}, xb = (pg8::f32x4){bf_lo(xw[2]), bf_hi(xw[2]), bf_lo(xw[3]), bf_hi(xw[3])};
                ss += (xa[0] * xa[0] + xa[1] * xa[1]) + (xa[2] * xa[2] + xa[3] * xa[3]) + (xb[0] * xb[0] + xb[1] * xb[1]) + (xb[2] * xb[2] + xb[3] * xb[3]);
                { v2u h8; h8.x = pk4_fp8(xa[0], xa[1], xa[2], xa[3]); h8.y = pk4_fp8(xb[0], xb[1], xb[2], xb[3]); *(GAS v2u*)(hp + 32 * s2) = h8; }
                const int co = ((4 * s2 + q) ^ sw) << 4;
                const bf16x8 bh0 = *(const LAS bf16x8*)(wb + co), bh1 = *(const LAS bf16x8*)(wb + 16 * 2048 + co), bl0 = *(const LAS bf16x8*)(wb + 32 * 2048 + co), bl1 = *(const LAS bf16x8*)(wb + 48 * 2048 + co);
                a0 = __builtin_amdgcn_mfma_f32_16x16x32_bf16(xr[s2], bh0, a0, 0, 0, 0); a1 = __builtin_amdgcn_mfma_f32_16x16x32_bf16(xr[s2], bh1, a1, 0, 0, 0);
                a0 = __builtin_amdgcn_mfma_f32_16x16x32_bf16(xr[s2], bl0, a0, 0, 0, 0); a1 = __builtin_amdgcn_mfma_f32_16x16x32_bf16(xr[s2], bl1, a1, 0, 0, 0);
            }
            ss += __shfl_xor(ss, 16); ss += __shfl_xor(ss, 32);
            rstd = 1.f / sqrtf(ss * (1.f / DM) + RMS_EPS);
            const float b0 = F.b_router[r], b1 = F.b_router[16 + r];
#pragma unroll
            for (int i = 0; i < 4; ++i) { const float rs = __shfl(rstd, 4 * q + i); lg[(4 * q + i) * 36 + r] = a0[i] * rs + b0; lg[(4 * q + i) * 36 + 16 + r] = a1[i] * rs + b1; }
            LDS_WAIT(); asm volatile("" ::: "memory");
            if (lane < 16) {
                float v[32];
#pragma unroll
                for (int j = 0; j < 8; ++j) { const pg8::f32x4 t4 = *(const LAS pg8::f32x4*)(lg + lane * 36 + 4 * j); v[4 * j] = t4[0]; v[4 * j + 1] = t4[1]; v[4 * j + 2] = t4[2]; v[4 * j + 3] = t4[3]; }
                unsigned taken = 0u; float tv[4];
#pragma unroll
                for (int k = 0; k < 4; ++k) { float best = -3.0e38f; int bi = 0;
#pragma unroll
                    for (int e = 0; e < 32; ++e) { const bool c = !((taken >> e) & 1u) && (v[e] > best); best = c ? v[e] : best; bi = c ? e : bi; }
                    taken |= 1u << bi; pe[k] = bi; tv[k] = best; }
                const float e1 = __expf(tv[1] - tv[0]), e2 = __expf(tv[2] - tv[0]), e3 = __expf(tv[3] - tv[0]); const float inv = 1.f / (1.f + e1 + e2 + e3);
                pw[0] = inv; pw[1] = e1 * inv; pw[2] = e2 * inv; pw[3] = e3 * inv;
#pragma unroll
                for (int k = 0; k < 4; ++k) pl[k] = __hip_atomic_fetch_add(lcnt + pe[k], 1, __ATOMIC_RELAXED, __HIP_MEMORY_SCOPE_WORKGROUP);
            }
        }
        __syncthreads();
        if (F.tid < 32) lbase[F.tid] = (int)__hip_atomic_fetch_add(F.ctl + CW_CNT + 64 * F.tid, (unsigned)lcnt[F.tid], RLX_AGENT);
        __syncthreads();
        if (w < 4 && lane < 16) { const int tok = row0 + lane;
#pragma unroll
            for (int k = 0; k < 4; ++k) { const int e = pe[k], pos = lbase[e] + pl[k]; ltok[e * CAP + pos] = tok; lgate[e * CAP + pos] = pw[k]; lrstd[e * CAP + pos] = rstd; toke[tok * 4 + k] = e; tokp[tok * 4 + k] = pos; } }
    }
}
__device__ __forceinline__ void build_tables(Frame& F) {
    __syncthreads();
    if (F.tid < 32) F.TAB[F.tid] = (int)__hip_atomic_load(F.ctl + CW_CNT + 64 * F.tid, RLX_AGENT);
    __syncthreads();
    if (F.tid <= 32) { int acc = 0; for (int e = 0; e < F.tid; ++e) acc += (F.TAB[e] + 255) >> 8; F.TAB[32 + F.tid] = acc; }
    __syncthreads();
    if (F.tid < NRT_MAX && F.tid < F.TAB[64]) { int e = 0;
#pragma unroll 1
        for (int j = 1; j < 32; ++j) e = (F.TAB[32 + j] <= F.tid) ? j : e;
        while (e > 0 && F.TAB[32 + e] == F.TAB[32 + e + 1]) --e;
        F.TAB[72 + F.tid] = e; }
    __syncthreads();
}

__device__ __forceinline__ void p8_final(Frame& F) {
    const bf16* X1 = WSP(bf16, WS_X1); const unsigned char* Y = WSP(unsigned char, WS_Y); const int* toke = WSP(int, WS_TOKE); const int* tokp = WSP(int, WS_TOKP);
    int lane = F.lane; asm volatile("" : "+v"(lane));
    const int gw = F.vcu * NWAVES + F.wave, NGW = F.G * NWAVES;
    const GAS f32x4* gp = (const GAS f32x4*)F.final_g + lane; f32x4 g[4];
#pragma unroll
    for (int j = 0; j < 4; ++j) g[j] = gp[64 * j];
    for (int m = gw; m < T_TOK; m += NGW) {
        const GAS v2u* xr = (const GAS v2u*)(X1 + (size_t)m * DM) + lane; f32x4 v[4];
#pragma unroll
        for (int j = 0; j < 4; ++j) { const v2u xw = xr[64 * j]; v[j] = (f32x4){bf_lo(xw.x), bf_hi(xw.x), bf_lo(xw.y), bf_hi(xw.y)}; }
#pragma unroll
        for (int k = 0; k < 4; ++k) { const int e = toke[m * 4 + k], pos = tokp[m * 4 + k]; const size_t slot = (size_t)F.TAB[32 + e] * 256 + pos;
            const GAS unsigned* yr = (const GAS unsigned*)(Y + slot * 1024) + lane;
#pragma unroll
            for (int j = 0; j < 4; ++j) { const unsigned yv = yr[64 * j]; const f32x2_t lo = __builtin_amdgcn_cvt_pk_f32_fp8((int)yv, false), hi = __builtin_amdgcn_cvt_pk_f32_fp8((int)yv, true);
                v[j].x += lo[0]; v[j].y += lo[1]; v[j].z += hi[0]; v[j].w += hi[1]; } }
        float s2 = 0.f;
#pragma unroll
        for (int j = 0; j < 4; ++j) s2 += (v[j].x * v[j].x + v[j].y * v[j].y) + (v[j].z * v[j].z + v[j].w * v[j].w);
        const float rstd = 1.f / sqrtf(wave_sum(s2) * (1.f / DM) + RMS_EPS);
        GAS f32x4* o = (GAS f32x4*)(F.out + (size_t)m * DM) + lane;
#pragma unroll
        for (int j = 0; j < 4; ++j) o[64 * j] = v[j] * rstd * g[j];
    }
}

struct Args { const float* in[18]; float* out; unsigned char* ws; int ph_lo, ph_hi; };
__global__ void __launch_bounds__(NWAVES * 64, 2) mk_fwd(Args args) {
    extern __shared__ __attribute__((aligned(16))) unsigned char lds[];
    Frame F;
    F.lds = (LAS unsigned char*)lds;
    F.MISC = (volatile LAS unsigned*)(F.lds + MISC_OFF);
    F.TAB = (LAS int*)(F.lds + TAB_OFF);
    F.tid = threadIdx.x; F.lane = F.tid & 63; F.wave = __builtin_amdgcn_readfirstlane(F.tid >> 6);
    F.G = gridDim.x; F.bx = (int)blockIdx.x; F.xloc = 0; F.vcu = (F.G % 8 == 0) ? (F.bx % 8) * (F.G / 8) + F.bx / 8 : F.bx;
    F.ws = args.ws; F.ctl = (gu32*)(args.ws + WS_CTL); F.out = args.out;
    F.x = args.in[0]; F.norm1_g = args.in[1]; F.w_in = args.in[2]; F.pool_w = args.in[3]; F.pool_scale = args.in[4]; F.w_pool_proj = args.in[5]; F.sinks = args.in[6]; F.w_attn_proj = args.in[7];
    F.w_out = args.in[8]; F.norm2_g = args.in[9]; F.w_router = args.in[10]; F.b_router = args.in[11]; F.w_up = args.in[12]; F.b_up = args.in[13]; F.w_down = args.in[14]; F.b_down = args.in[15];
    F.rel_bias = args.in[16]; F.final_g = args.in[17];
    for (int u = F.tid; u < (LDS_BYTES - LDSCTL_OFF) / 4; u += NWAVES * 64) ((LAS unsigned*)(F.lds + LDSCTL_OFF))[u] = 0u;
    __syncthreads();
    XcdBarrier bar; bar.bar = (unsigned*)(F.ctl + CW_BAR); bar.x = 0; bar.st = nullptr;
    if (N_LAUNCHES == 1) bar = xcd_barrier_post((unsigned*)(F.ctl + CW_BAR), F.MISC + 8);
#define GRID_BAR() do { if (N_LAUNCHES == 1) xcd_barrier(bar); } while (0)
    const int lo = args.ph_lo, hi = args.ph_hi;
#ifndef PHASE_MASK
#define PHASE_MASK 0x1ff
#endif
#define IN(k) ((((PHASE_MASK) >> (k)) & 1) && lo <= (k) && (k) < hi)
    using pg8::StaticOrder;
#ifndef REP_MASK
#define REP_MASK 0
#endif
#define REP(k) (((REP_MASK) >> (k)) & 1)
#define PH0() do { p0_prologue(F); } while (0)
#define PH1() do { { ProbDense P{(const char*)WSP(bf16, WS_H1), (const char*)WSP(bf16, WS_WIN)}; EpiInProj E{WSP(bf16, WS_U), WSP(bf16, WS_Q), WSP(bf16, WS_KV), WSP(bf16, WS_GP), WSP(bf16, WS_GA)}; \
            if (F.G == 256) { P1Order S{F.bx & 7, F.bx >> 3, 0}; pg8::gemm_phase<ProbDense, EpiInProj, P1Order, true>(F.lds + RING_OFF, P, S, E); } \
            else { StaticOrderPn2 S; S.init(T_TOK / 256, 3, F.G, F.bx); pg8::gemm_phase<ProbDense, EpiInProj, StaticOrderPn2, true>(F.lds + RING_OFF, P, S, E); } } \
        { ProbDense8 P{(const char*)WSP(unsigned char, WS_H18), (const char*)WSP(unsigned char, WS_WIN8)}; EpiGate8 E{WSP(unsigned char, WS_GP), WSP(unsigned char, WS_GA), WSP(bf16, WS_Q)}; \
            if (F.G == 256) { P1Order S{F.bx & 7, F.bx >> 3, 1}; pg8::gemm_phase<ProbDense8, EpiGate8, P1Order, true>(F.lds + RING_OFF, P, S, E); } \
            else { StaticOrder S; S.init(T_TOK / 256, 10, F.G, F.bx); pg8::gemm_phase<ProbDense8, EpiGate8, StaticOrder, true>(F.lds + RING_OFF, P, S, E); } } } while (0)
#ifndef CV_A
#define CV_A 3
#endif
#ifndef CV_B
#define CV_B 5
#endif
#define STG_RANK (((F.bx >> 4) << 3) + (F.bx & 7))
#define STG_PRE_W(W_, base, cvb) do { if (F.G == 256 && ((F.bx >> 3) & 1)) convert_moe_w<W_>(F, (base), (base) + 128 * (cvb), STG_RANK, 128); } while (0)
#define STG_POST_W(W_, base, cva, cvb) do { if (F.G == 256) { if (!((F.bx >> 3) & 1)) convert_moe_w<W_>(F, (base) + 128 * (cvb), (base) + 128 * ((cva) + (cvb)), STG_RANK, 128); } \
        else convert_moe_w<W_>(F, (base), (base) + 128 * ((cva) + (cvb)), F.vcu, F.G); } while (0)
#define STG_PRE(base, cvb) STG_PRE_W(1, base, cvb)
#define STG_POST(base, cva, cvb) STG_POST_W(1, base, cva, cvb)
#ifndef CV2_A
#define CV2_A 0
#endif
#ifndef CV2_B
#define CV2_B 0
#endif
#define CV_P2BASE (2 * 128 * (CV_A + CV_B))
#define CV_P5BASE (CV_P2BASE + 128 * (CV2_A + CV2_B))
#define PH2() do { if (F.xloc) STG_PRE_W(0, 0, 2); p2_attn_pool(F); if (F.xloc) STG_POST_W(0, 0, 1, 2); } while (0)
#define PH3_PRE() STG_PRE(0, CV_B)
#define PH3_MAIN() do { { ProbDense P{(const char*)WSP(bf16, WS_ZA), (const char*)WSP(bf16, WS_WMIX)}; StaticOrder S; S.init(T_TOK / 256, DM / 256, F.G, F.bx); \
        EpiMix E{WSP(unsigned char, WS_GP), WSP(unsigned char, WS_GA), WSP(bf16, WS_MIX)}; \
        pg8::gemm_phase<ProbDense, EpiMix, StaticOrder, true>(F.lds + RING_OFF, P, S, E); } STG_POST(0, CV_A, CV_B); } while (0)
#define PH3() do { PH3_PRE(); PH3_MAIN(); } while (0)
#define PH4_PRE() STG_PRE(128 * (CV_A + CV_B), CV_B)
#define PH4_MAIN() do { { ProbDense P{(const char*)WSP(bf16, WS_MIX), (const char*)WSP(bf16, WS_WOUT)}; StaticOrder S; S.init(T_TOK / 256, DM / 256, F.G, F.bx); \
        EpiOut E{F.x, WSP(bf16, WS_X1)}; \
        pg8::gemm_phase<ProbDense, EpiOut, StaticOrder, true>(F.lds + RING_OFF, P, S, E); } STG_POST(128 * (CV_A + CV_B), CV_A, CV_B); } while (0)
#define PH4() do { PH4_PRE(); PH4_MAIN(); } while (0)
#ifndef CV5_A
#define CV5_A 2
#endif
#ifndef CV5_B
#define CV5_B 3
#endif
#define DN_P1BASE (DN_SPLIT + 128 * (CV5_A + CV5_B))
#define PH5_PRE() STG_PRE_W(0, DN_SPLIT, CV5_B)
#define PH5_MAIN() do { p5_router(F); convert_moe_w<1>(F, CV_P5BASE, NEXP * 64, F.vcu, F.G); STG_POST_W(0, DN_SPLIT, CV5_A, CV5_B); } while (0)
#define PH5() do { PH5_PRE(); PH5_MAIN(); } while (0)
#define PH6() do { ProbUp P{(const char*)WSP(bf16, WS_H2), (const char*)WSP(bf16, WS_WUP), WSP(int, WS_LTOK), F.TAB}; EpiUp E{F.b_up, WSP(float, WS_LRSTD), WSP(unsigned char, WS_ACT), F.TAB, F.lds}; \
        const int nrt = __builtin_amdgcn_readfirstlane(F.TAB[64]); \
        if (F.xloc) { pg8::XccProducer S; S.init(nrt, 8, F.bx & 7, F.bx >> 3, 0); S.cnt = (unsigned*)(F.ctl + CW_RTC); pg8::gemm_phase<ProbUp, EpiUp, pg8::XccProducer, true>(F.lds + RING_OFF, P, S, E); } \
        else { StaticOrder S; S.init(nrt, 8, F.G, F.bx); pg8::gemm_phase<ProbUp, EpiUp, StaticOrder, true>(F.lds + RING_OFF, P, S, E); \
            { const int nwg = S.nwg, R = (nwg + F.G - 1) / F.G, nidle = R * F.G - nwg, c = F.bx; \
              if (nidle == 0) convert_moe_w<0>(F, 0, DN_SPLIT, c, F.G); else if (c >= F.G - nidle) convert_moe_w<0>(F, 0, DN_SPLIT, c - (F.G - nidle), nidle); } } } while (0)
#define PH7() do { ProbDown P{(const char*)WSP(bf16, WS_ACT), (const char*)WSP(bf16, WS_WDN), F.TAB}; EpiDown E{F.b_down, WSP(float, WS_LGATE), WSP(unsigned char, WS_Y), F.TAB, F.lds}; \
        const int nrt = __builtin_amdgcn_readfirstlane(F.TAB[64]); \
        if (F.xloc) { pg8::XccConsumer S; { pg8::XccOrder U; U.init(nrt, 8, F.bx & 7, F.bx >> 3, 0); S.init(nrt, 4, F.bx & 7, F.bx >> 3, U.n); } S.cnt = (unsigned*)(F.ctl + CW_RTC); S.tmo = (unsigned*)(F.ctl + CW_TMO); \
            pg8::gemm_phase<ProbDown, EpiDown, pg8::XccConsumer, true>(F.lds + RING_OFF, P, S, E); } \
        else { StaticOrder S; S.init(nrt, 4, F.G, F.bx); pg8::gemm_phase<ProbDown, EpiDown, StaticOrder, true>(F.lds + RING_OFF, P, S, E); } } while (0)
#define PH8() do { p8_final(F); } while (0)
    if (IN(0)) { PH0(); GRID_BAR(); if (REP(0)) { PH0(); GRID_BAR(); } }
    if (N_LAUNCHES == 1 && lo == 0) {
        if (F.tid == 0) { int rank = 0, dense = 0; const int ok = xcc_layout(bar, rank, dense); F.MISC[12] = (unsigned)ok; F.MISC[13] = (unsigned)(rank * 8 + dense); }
        __syncthreads();
        if (F.MISC[12]) { F.xloc = 1; F.bx = (int)F.MISC[13]; F.vcu = (F.bx % 8) * (F.G / 8) + F.bx / 8; }
    }
#define LOCAL_BAR() do { if (N_LAUNCHES == 1) { if (F.xloc) xcc_barrier(bar); else xcd_barrier(bar); } } while (0)
    if (IN(1)) { PH1(); GRID_BAR(); if (REP(1)) { PH1(); GRID_BAR(); } }
#define SPLIT_SEAM(PRE) do { if (N_LAUNCHES == 1 && F.xloc) { const unsigned g_ = xcc_arrive(bar); PRE; xcc_wait(bar, g_); } else { GRID_BAR(); PRE; } } while (0)
    if (IN(2)) { PH2(); if (IN(3) && !REP(2)) SPLIT_SEAM(PH3_PRE()); else { LOCAL_BAR(); if (REP(2)) { PH2(); LOCAL_BAR(); } if (IN(3)) PH3_PRE(); } }
    if (IN(3)) { if (!IN(2)) PH3_PRE(); PH3_MAIN(); if (IN(4) && !REP(3)) SPLIT_SEAM(PH4_PRE()); else { LOCAL_BAR(); if (REP(3)) { PH3(); LOCAL_BAR(); } if (IN(4)) PH4_PRE(); } }
    if (IN(4)) { if (!IN(3)) PH4_PRE(); PH4_MAIN(); if (IN(5) && !REP(4)) SPLIT_SEAM(PH5_PRE()); else { LOCAL_BAR(); if (REP(4)) { PH4(); LOCAL_BAR(); } if (IN(5)) PH5_PRE(); } }
    if (IN(5)) { if (!IN(4)) PH5_PRE(); PH5_MAIN(); GRID_BAR(); if (REP(5)) { if (blockIdx.x == 0 && F.tid < 32) __hip_atomic_store(F.ctl + CW_CNT + 64 * F.tid, 0u, RLX_AGENT); GRID_BAR(); PH5(); GRID_BAR(); } }
    if (IN(6) || IN(7) || IN(8)) build_tables(F);
    if (IN(6)) { PH6(); if (!F.xloc) GRID_BAR(); if (REP(6)) { PH6(); GRID_BAR(); } }
    if (IN(7)) { PH7(); GRID_BAR(); if (REP(7)) { PH7(); GRID_BAR(); } }
    if (IN(8)) { PH8(); if (REP(8)) { GRID_BAR(); PH8(); } }
#undef IN
}

extern "C" void kernel_launch(void* const* d_in, const int* in_sizes, int n_in, void* d_out, int out_size, void* d_ws, size_t ws_size, hipStream_t stream) {
    static int grid = 0;
    if (grid == 0) {
        if (n_in != 18 || out_size != T_TOK * DM || ws_size < WS_END) { fprintf(stderr, "kernel_launch: unexpected problem (n_in %d out %d ws %zu)\n", n_in, out_size, ws_size); grid = -1; return; }
        int dev = 0, cus = 0, per_cu = 0;
        if (hipGetDevice(&dev) != hipSuccess || hipDeviceGetAttribute(&cus, hipDeviceAttributeMultiprocessorCount, dev) != hipSuccess) { grid = -1; return; }
        if (hipFuncSetAttribute((const void*)mk_fwd, hipFuncAttributeMaxDynamicSharedMemorySize, LDS_BYTES) != hipSuccess) { fprintf(stderr, "kernel_launch: hipFuncSetAttribute failed\n"); grid = -1; return; }
        if (hipOccupancyMaxActiveBlocksPerMultiprocessor(&per_cu, (const void*)mk_fwd, NWAVES * 64, LDS_BYTES) != hipSuccess || per_cu < 1) fprintf(stderr, "kernel_launch: occupancy query says %d\n", per_cu);
        (void)hipGetLastError();
        grid = cus;
    }
    if (grid < 0) return;
    if (hipMemsetAsync((char*)d_ws + WS_CTL, 0, CTL_ZERO_BYTES, stream) != hipSuccess) return;
    Args a{};
    for (int i = 0; i < 18; ++i) a.in[i] = (const float*)d_in[i];
    a.out = (float*)d_out; a.ws = (unsigned char*)d_ws;
    if (N_LAUNCHES == 1) { a.ph_lo = 0; a.ph_hi = PER_PHASE; hipLaunchKernelGGL(mk_fwd, dim3(grid), dim3(NWAVES * 64), LDS_BYTES, stream, a); }
    else { for (int p = 0; p < PER_PHASE; ++p) { a.ph_lo = p; a.ph_hi = p + 1; hipLaunchKernelGGL(mk_fwd, dim3(grid), dim3(NWAVES * 64), LDS_BYTES, stream, a); } }
}
```
